# Optimizing an MI355X kernel written in HIP

```python
import jax, jax.numpy as jnp
from jax import lax
import numpy as np

D_MODEL = 2048
BATCH = 1
SEQ = 8192
DEPTH = 1

CTX_LEN = 256
GRID_W = 64
HEAD_DIM = 64
N_Q_HEADS = D_MODEL // (2 * HEAD_DIM)
N_KV_HEADS = N_Q_HEADS // 4
ATTN_WIDTH = N_Q_HEADS * HEAD_DIM
KV_WIDTH = N_KV_HEADS * HEAD_DIM
POOL_WINDOWS = (2, 4, 8, 16)
POOL_GROUPS = len(POOL_WINDOWS)
POOL_WIDTH = D_MODEL - ATTN_WIDTH
POOL_GROUP_DIM = POOL_WIDTH // POOL_GROUPS
MIX_WIDTH = ATTN_WIDTH + POOL_WIDTH
IN_WIDTH = ATTN_WIDTH + 2 * KV_WIDTH + POOL_WIDTH
D_FF = 4 * D_MODEL
WINDOW = 128
BLOCK = 128
ROPE_BASE = 10000.0
N_MOD = 6
EPS = 1e-6
NEG_INF = -1e30

kernel_name = "hymba_style_window_gqa_pool_diffusion_block"


def rms_norm(x, w):
    xf = x.astype(jnp.float32)
    y = xf * lax.rsqrt(jnp.mean(xf * xf, axis=-1, keepdims=True) + EPS)
    return (y * w.astype(jnp.float32)).astype(x.dtype)


def ada_modulation(cond, w, b):
    m = jax.nn.silu(cond) @ w + b
    return jnp.split(m[..., None, :], N_MOD, axis=-1)


def modulate(h, shift, scale):
    return h * (1.0 + scale) + shift


def split_projection(p):
    B, L, _ = p.shape
    q, k, v, u = jnp.split(p, [ATTN_WIDTH, ATTN_WIDTH + KV_WIDTH, ATTN_WIDTH + 2 * KV_WIDTH], axis=-1)
    return (q.reshape(B, L, N_Q_HEADS, HEAD_DIM), k.reshape(B, L, N_KV_HEADS, HEAD_DIM),
            v.reshape(B, L, N_KV_HEADS, HEAD_DIM), u)


def axial_positions(seq_len):
    rows = seq_len // GRID_W
    row = jnp.broadcast_to(jnp.arange(rows)[:, None], (rows, GRID_W)).reshape(-1)
    col = jnp.broadcast_to(jnp.arange(GRID_W)[None, :], (rows, GRID_W)).reshape(-1)
    return row, col


def rope_2d(x, row, col):
    half = HEAD_DIM // 2
    inv_freq = ROPE_BASE ** (-jnp.arange(0, half, 2, dtype=jnp.float32) / half)

    def rot(xa, pos):
        ang = pos.astype(jnp.float32)[:, None] * inv_freq[None, :]
        cos = jnp.cos(ang)[None, :, None, :]
        sin = jnp.sin(ang)[None, :, None, :]
        x1, x2 = jnp.split(xa, 2, axis=-1)
        return jnp.concatenate([x1 * cos - x2 * sin, x1 * sin + x2 * cos], axis=-1)

    xf = x.astype(jnp.float32)
    out = jnp.concatenate([rot(xf[..., :half], row), rot(xf[..., half:], col)], axis=-1)
    return out.astype(x.dtype)


def latent_window_attention(q, k, v, k_ctx, v_ctx, sink):
    B, L, H, D = q.shape
    G = H // N_KV_HEADS
    nb = L // BLOCK
    scale = HEAD_DIM ** -0.5
    qb = q.reshape(B, nb, BLOCK, N_KV_HEADS, G, D)
    pad = ((0, 0), (BLOCK, BLOCK), (0, 0), (0, 0))
    kp = jnp.pad(k, pad).reshape(B, nb + 2, BLOCK, N_KV_HEADS, D)
    vp = jnp.pad(v, pad).reshape(B, nb + 2, BLOCK, N_KV_HEADS, D)
    kb = jnp.concatenate([kp[:, :-2], kp[:, 1:-1], kp[:, 2:]], axis=2)
    vb = jnp.concatenate([vp[:, :-2], vp[:, 1:-1], vp[:, 2:]], axis=2)
    s_win = jnp.einsum('bnqhgd,bnkhd->bhgnqk', qb, kb).astype(jnp.float32) * scale
    blk = jnp.arange(nb)[:, None, None] * BLOCK
    qpos = blk + jnp.arange(BLOCK)[None, :, None]
    kpos = blk - BLOCK + jnp.arange(3 * BLOCK)[None, None, :]
    valid = (jnp.abs(qpos - kpos) <= WINDOW) & (kpos >= 0) & (kpos < L)
    s_win = jnp.where(valid, s_win, NEG_INF)
    s_ctx = jnp.einsum('bnqhgd,bchd->bhgnqc', qb, k_ctx).astype(jnp.float32) * scale
    s_sink = jnp.broadcast_to(sink.astype(jnp.float32).reshape(N_KV_HEADS, G)[None, :, :, None, None, None],
                              s_win.shape[:-1] + (1,))
    p = jax.nn.softmax(jnp.concatenate([s_win, s_ctx, s_sink], axis=-1), axis=-1)
    n_win = 3 * BLOCK
    n_ctx = k_ctx.shape[1]
    p_win = p[..., :n_win].astype(v.dtype)
    p_ctx = p[..., n_win:n_win + n_ctx].astype(v.dtype)
    out = (jnp.einsum('bhgnqk,bnkhd->bnqhgd', p_win, vb)
           + jnp.einsum('bhgnqc,bchd->bnqhgd', p_ctx, v_ctx))
    return out.reshape(B, L, H * D)


def context_attention(q, k, v, sink):
    B, C, H, D = q.shape
    G = H // N_KV_HEADS
    qg = q.reshape(B, C, N_KV_HEADS, G, D)
    s = jnp.einsum('bqhgd,bkhd->bhgqk', qg, k).astype(jnp.float32) * (HEAD_DIM ** -0.5)
    s_sink = jnp.broadcast_to(sink.astype(jnp.float32).reshape(N_KV_HEADS, G)[None, :, :, None, None],
                              s.shape[:-1] + (1,))
    p = jax.nn.softmax(jnp.concatenate([s, s_sink], axis=-1), axis=-1)[..., :C].astype(v.dtype)
    out = jnp.einsum('bhgqk,bkhd->bqhgd', p, v)
    return out.reshape(B, C, H * D)


def multiscale_pool(u, pool_w, pool_scale):
    B, L, _ = u.shape
    uf = u.astype(jnp.float32)
    csum = jnp.pad(jnp.cumsum(uf, axis=1), ((0, 0), (1, 0), (0, 0)))
    t = jnp.arange(L)
    outs = []
    for g, w in enumerate(POOL_WINDOWS):
        lo = jnp.clip(t - w // 2, 0, L)
        hi = jnp.clip(t - w // 2 + w, 0, L)
        cs = csum[..., g * POOL_GROUP_DIM:(g + 1) * POOL_GROUP_DIM]
        mean = (cs[:, hi] - cs[:, lo]) / (hi - lo).astype(jnp.float32)[None, :, None]
        outs.append(mean - uf[..., g * POOL_GROUP_DIM:(g + 1) * POOL_GROUP_DIM])
    pooled = jnp.stack(outs, axis=2)
    mixed = jnp.einsum('blgc,gcd->blgd', pooled, pool_w.astype(jnp.float32)).reshape(B, L, POOL_WIDTH)
    return (mixed * pool_scale.astype(jnp.float32)).astype(u.dtype)


def squared_relu_mlp(h, w_up, w_down):
    return jnp.square(jax.nn.relu(h @ w_up)) @ w_down


def setup_inputs(seed: int = 0) -> dict:
    key = jax.random.key(seed)
    ks = jax.random.split(key, 18)
    f32 = jnp.float32
    nrm = lambda k, shape, s: jax.random.normal(k, shape, f32) * s
    return {
        "x": nrm(ks[0], (BATCH, SEQ, D_MODEL), 1.0),
        "c": nrm(ks[1], (BATCH, D_MODEL), 1.0),
        "ctx": nrm(ks[2], (BATCH, CTX_LEN, D_MODEL), 1.0),
        "c_ctx": nrm(ks[3], (D_MODEL,), 1.0),
        "norm_attn_w": 1.0 + nrm(ks[4], (DEPTH, D_MODEL), 0.02),
        "norm_mlp_w": 1.0 + nrm(ks[5], (DEPTH, D_MODEL), 0.02),
        "w_ada": nrm(ks[6], (DEPTH, D_MODEL, N_MOD * D_MODEL), 0.5 * D_MODEL ** -0.5),
        "b_ada": nrm(ks[7], (DEPTH, N_MOD * D_MODEL), 0.02),
        "w_in": nrm(ks[8], (DEPTH, D_MODEL, IN_WIDTH), D_MODEL ** -0.5),
        "attn_sink": nrm(ks[9], (DEPTH, N_Q_HEADS), 1.0),
        "pool_w": nrm(ks[10], (DEPTH, POOL_GROUPS, POOL_GROUP_DIM, POOL_GROUP_DIM), POOL_GROUP_DIM ** -0.5),
        "pool_scale": 1.0 + nrm(ks[11], (DEPTH, POOL_WIDTH), 0.1),
        "w_out": nrm(ks[12], (DEPTH, MIX_WIDTH, D_MODEL), MIX_WIDTH ** -0.5),
        "w_mlp_up": nrm(ks[13], (DEPTH, D_MODEL, D_FF), D_MODEL ** -0.5),
        "w_mlp_down": nrm(ks[14], (DEPTH, D_FF, D_MODEL), D_FF ** -0.5),
        "final_norm_w": 1.0 + nrm(ks[15], (D_MODEL,), 0.02),
    }


def reference(x, c, ctx, c_ctx, norm_attn_w, norm_mlp_w, w_ada, b_ada, w_in, attn_sink,
              pool_w, pool_scale, w_out, w_mlp_up, w_mlp_down, final_norm_w):
    seq_len = x.shape[1]
    row, col = axial_positions(seq_len)
    for layer in range(DEPTH):
        sh_a, sc_a, g_a, sh_m, sc_m, g_m = ada_modulation(c, w_ada[layer], b_ada[layer])
        csh_a, csc_a, cg_a, csh_m, csc_m, cg_m = ada_modulation(c_ctx, w_ada[layer], b_ada[layer])

        h = modulate(rms_norm(x, norm_attn_w[layer]), sh_a, sc_a)
        hc = modulate(rms_norm(ctx, norm_attn_w[layer]), csh_a, csc_a)
        q, k, v, u = split_projection(h @ w_in[layer])
        qc, kc, vc, uc = split_projection(hc @ w_in[layer])
        q = rope_2d(q, row, col)
        k = rope_2d(k, row, col)
        attn = latent_window_attention(q, k, v, kc, vc, attn_sink[layer])
        pool = multiscale_pool(u, pool_w[layer], pool_scale[layer])
        x = x + g_a * (jnp.concatenate([attn, pool], axis=-1) @ w_out[layer])

        hm = modulate(rms_norm(x, norm_mlp_w[layer]), sh_m, sc_m)
        x = x + g_m * squared_relu_mlp(hm, w_mlp_up[layer], w_mlp_down[layer])

        if layer < DEPTH - 1:
            attn_c = context_attention(qc, kc, vc, attn_sink[layer])
            pool_c = multiscale_pool(uc, pool_w[layer], pool_scale[layer])
            ctx = ctx + cg_a * (jnp.concatenate([attn_c, pool_c], axis=-1) @ w_out[layer])
            hcm = modulate(rms_norm(ctx, norm_mlp_w[layer]), csh_m, csc_m)
            ctx = ctx + cg_m * squared_relu_mlp(hcm, w_mlp_up[layer], w_mlp_down[layer])
    return rms_norm(x, final_norm_w)
```

```cpp
#include <hip/hip_runtime.h>
#include <hip/hip_cooperative_groups.h>
#include <cstdio>
#include <cstdint>
namespace cg = cooperative_groups;
#ifndef NL
#define NL 1
#endif
namespace pg8 {
#define PG8_LAS __attribute__((address_space(3)))
typedef unsigned short bf16_t;
typedef short bf16x8 __attribute__((ext_vector_type(8)));
typedef float f32x4 __attribute__((ext_vector_type(4)));
typedef unsigned u32x4 __attribute__((ext_vector_type(4)));
constexpr int BM = 256, BK = 64, HALF = 128, HTB = HALF * BK * 2  , STAGE_BYTES = 8 * HTB, NXCD = 8, WGM = 8;

__host__ __device__ __forceinline__ int lds_byte(int r, int c) { const int st = (r >> 4) * 2 + (c >> 5), rr = r & 15, cc = c & 31, ob = rr * 64 + cc * 2; return st * 1024 + (ob ^ (((ob >> 9) & 1) << 5)); }
__host__ __device__ __forceinline__ void stage_rc(int b, int& R, int& C) { const int st = b / 1024, sb = b % 1024, swz = sb ^ (((sb >> 9) & 1) << 5); R = (st >> 1) * 16 + swz / 64; C = (st & 1) * 32 + (swz % 64) / 2; }
__host__ __device__ __forceinline__ int perm32(int rho) { const int n = rho >> 4, i = rho & 15; return 8 * (i >> 2) + 4 * n + (i & 3); }

struct Unit { int pm, pn; };
struct Gemm { const bf16_t* A; const bf16_t* Bt; int M, N, K; };

struct StaticOrder {
    int nM, nN, nwg, G, c;
    __host__ __device__ void init(int M, int N, int G_, int c_) { nM = M / BM; nN = N / BM; nwg = nM * nN; G = G_; c = c_; }
    __host__ __device__ bool next(int i, Unit& u) const {
        const long L = (long)i * G + c; if (L >= nwg) return false;
        int wgid = (int)L; { const int q = nwg / NXCD, r = nwg % NXCD, xcd = wgid % NXCD, off = wgid / NXCD; wgid = (xcd < r ? xcd * (q + 1) : r * (q + 1) + (xcd - r) * q) + off; }
        const int nig = WGM * nN, gid = wgid / nig, fm = gid * WGM, gsz = (nM - fm) < WGM ? (nM - fm) : WGM;
        u.pm = fm + ((wgid % nig) % gsz); u.pn = (wgid % nig) / gsz; return true;
    }
    __device__ __forceinline__ void a_ready(const Unit&) const {}
    __device__ __forceinline__ void done(const Unit&) const {}
};
__device__ __forceinline__ unsigned cvt_pk_bf16(float lo, float hi) { unsigned r; asm volatile("v_cvt_pk_bf16_f32 %0, %1, %2" : "=v"(r) : "v"(lo), "v"(hi)); return r; }
typedef float f32x2 __attribute__((ext_vector_type(2)));
typedef unsigned u32x2 __attribute__((ext_vector_type(2)));
constexpr float QSCALE = 0.125f * 1.4426950408889634f;

struct InProjOrder {
    StaticOrder so;
    __device__ void init(int G_, int c_) { so.init(8192, 2560, G_, c_); }
    __device__ bool next(int i, Unit& u) const {
        const long L = (long)i * so.G + so.c;
        if (L < 320) return so.next(i, u);
        if (L < 322) { u.pm = 32; u.pn = 4 + (int)(L - 320); return true; }
        return false;
    }
    __device__ __forceinline__ void a_ready(const Unit&) const {}
    __device__ __forceinline__ void done(const Unit&) const {}
};

struct EpiInProj {
    static constexpr bool PERM = false, AFTER_DRAIN = false;
    bf16_t* O; const float* rope;
    __device__ __forceinline__ void operator()(const f32x4 (&acc)[2][2][4][2], const Unit& u, int wr, int wc, int fr, int fq) const {
        const bool dorope = (u.pm < 32) && (u.pn < 5);
        const float qs = (u.pn < 4) ? QSCALE : 1.f;
        const int col0 = u.pn * BM + wc * 32 + 4 * fq;
#pragma unroll
        for (int ai = 0; ai < 2; ++ai)
#pragma unroll
            for (int m = 0; m < 4; ++m) {
                const int r = u.pm * BM + ai * HALF + wr * 64 + m * 16 + fr;
                f32x4 cs = (f32x4){qs, qs, qs, qs}, sn = (f32x4){0.f, 0.f, 0.f, 0.f};
                if (dorope) { const int pos = (wc & 1) ? (r & 63) : (r >> 6);
                    cs = *(const f32x4*)(rope + pos * 16 + 4 * fq) * qs; sn = *(const f32x4*)(rope + 2048 + pos * 16 + 4 * fq) * qs; }
                bf16_t* rowp = O + (size_t)r * 2560 + col0;
#pragma unroll
                for (int bj = 0; bj < 2; ++bj) {
                    const f32x4 x1 = acc[ai][bj][m][0], x2 = acc[ai][bj][m][1];
                    const f32x4 o1 = x1 * cs - x2 * sn, o2 = x1 * sn + x2 * cs;
                    u32x2 w1, w2; w1.x = cvt_pk_bf16(o1[0], o1[1]); w1.y = cvt_pk_bf16(o1[2], o1[3]); w2.x = cvt_pk_bf16(o2[0], o2[1]); w2.y = cvt_pk_bf16(o2[2], o2[3]);
                    *(u32x2*)(rowp + bj * HALF) = w1; *(u32x2*)(rowp + bj * HALF + 16) = w2;
                }
            }
    }
};

struct EpiResGate {
    static constexpr bool PERM = false, AFTER_DRAIN = false;
    const float* base; float* out; const float* gate; int ldc;
    __device__ __forceinline__ void operator()(const f32x4 (&acc)[2][2][4][2], const Unit& u, int wr, int wc, int fr, int fq) const {
        const int col0 = u.pn * BM + wc * 32 + 4 * fq;
        f32x4 gv[2][2];
#pragma unroll
        for (int bj = 0; bj < 2; ++bj)
#pragma unroll
            for (int n = 0; n < 2; ++n) gv[bj][n] = *(const f32x4*)(gate + col0 + bj * HALF + n * 16);
#pragma unroll
        for (int ai = 0; ai < 2; ++ai)
#pragma unroll
            for (int m = 0; m < 4; ++m) {
                const size_t off = (size_t)(u.pm * BM + ai * HALF + wr * 64 + m * 16 + fr) * ldc + col0;
#pragma unroll
                for (int bj = 0; bj < 2; ++bj)
#pragma unroll
                    for (int n = 0; n < 2; ++n) { const f32x4 b = *(const f32x4*)(base + off + bj * HALF + n * 16); *(f32x4*)(out + off + bj * HALF + n * 16) = b + gv[bj][n] * acc[ai][bj][m][n]; }
                if (m & 1) asm volatile("" ::: "memory");
            }
    }
};

struct EpiRelu2 {
    static constexpr bool PERM = true, AFTER_DRAIN = false;
    bf16_t* O; int ldc;
    __device__ __forceinline__ void operator()(const f32x4 (&acc)[2][2][4][2], const Unit& u, int wr, int wc, int fr, int fq) const {
        const int row0 = u.pm * BM + wr * 64 + fr, col0 = u.pn * BM + wc * 32 + 8 * fq;
#pragma unroll
        for (int ai = 0; ai < 2; ++ai)
#pragma unroll
            for (int m = 0; m < 4; ++m) { bf16_t* rowp = O + (size_t)(row0 + ai * HALF + m * 16) * ldc + col0;
#pragma unroll
                for (int bj = 0; bj < 2; ++bj) { f32x4 v0 = acc[ai][bj][m][0], v1 = acc[ai][bj][m][1];
                    v0 = __builtin_elementwise_max(v0, (f32x4){0.f, 0.f, 0.f, 0.f}); v1 = __builtin_elementwise_max(v1, (f32x4){0.f, 0.f, 0.f, 0.f}); v0 = v0 * v0; v1 = v1 * v1;
                    u32x4 w; w.x = cvt_pk_bf16(v0[0], v0[1]); w.y = cvt_pk_bf16(v0[2], v0[3]); w.z = cvt_pk_bf16(v1[0], v1[1]); w.w = cvt_pk_bf16(v1[2], v1[3]);
                    *(u32x4*)(rowp + bj * HALF) = w; } }
    }
};

template <class Epi, class Sched, bool ALIGN_EPI = false, bool SP2 = false>
__device__ __forceinline__ void gemm_phase(PG8_LAS unsigned char* lds, const Gemm g, const Sched& S, const Epi& E) {
    const int tid = threadIdx.x, wid = __builtin_amdgcn_readfirstlane(tid >> 6), lane = tid & 63, wr = wid >> 2, wc = wid & 3, fr = lane & 15, fq = lane >> 4;
    const int K = g.K, nt = K / BK;
    unsigned voffA[2], voffB[2];
#pragma unroll
    for (int i = 0; i < 2; ++i) { int R, C; stage_rc(tid * 16 + i * 8192, R, C); const int Rb = Epi::PERM ? ((R & ~31) + perm32(R & 31)) : R;
        voffA[i] = (unsigned)(R * K + C) * 2u; voffB[i] = (unsigned)(Rb * K + C) * 2u; }
    const size_t kstep = (size_t)(BK * 2);
    const size_t hstep = (size_t)HALF * K * 2;
    const size_t tstep = 2 * hstep;
    const unsigned ldsw = (unsigned)wid * 1024u;
    const int aoff = lds_byte(wr * 64 + fr, fq * 8), boff = lds_byte(wc * 32 + fr, fq * 8);
#define PG8_SA(b, h) (((b) * 2 + (h)) * HTB)
#define PG8_SB(b, h) ((4 + (b) * 2 + (h)) * HTB)
#define PG8_STAGE(bufoff, gbase, voff) do { _Pragma("unroll") for (int _i = 0; _i < 2; ++_i) \
        __builtin_amdgcn_global_load_lds((const unsigned*)((const char*)(gbase) + (voff)[_i]), (PG8_LAS unsigned*)(lds + (bufoff) + ldsw + _i * 8192), 16, 0, 0); } while (0)
#define PG8_LDA(dst, b, h) do { _Pragma("unroll") for (int m = 0; m < 4; ++m) _Pragma("unroll") for (int k = 0; k < 2; ++k) dst[m][k] = *(const PG8_LAS bf16x8*)(lds + PG8_SA(b, h) + aoff + m * 2048 + k * 1024); } while (0)
#define PG8_LDB(dst, b, h) do { _Pragma("unroll") for (int n = 0; n < 2; ++n) _Pragma("unroll") for (int k = 0; k < 2; ++k) dst[n][k] = *(const PG8_LAS bf16x8*)(lds + PG8_SB(b, h) + boff + n * 2048 + k * 1024); } while (0)
#define PG8_MMA(ai, bj, At, Bt) do { __builtin_amdgcn_s_setprio(1); _Pragma("unroll") for (int m = 0; m < 4; ++m) _Pragma("unroll") for (int n = 0; n < 2; ++n) _Pragma("unroll") for (int k = 0; k < 2; ++k) \
        acc[ai][bj][m][n] = __builtin_amdgcn_mfma_f32_16x16x32_bf16(Bt[n][k], At[m][k], acc[ai][bj][m][n], 0, 0, 0); __builtin_amdgcn_s_setprio(0); } while (0)
#define PG8_WAIT_V(n) asm volatile("s_waitcnt vmcnt(" #n ")" ::: "memory")
#define PG8_WAIT_L(n) asm volatile("s_waitcnt lgkmcnt(" #n ")" ::: "memory")
#define PG8_BAR __builtin_amdgcn_s_barrier()
#define PG8_SCHED __builtin_amdgcn_sched_barrier(0)
    Unit cur, nxt; int ui = 0;
    if (!S.next(0, cur)) return;
    f32x4 acc[2][2][4][2];
#pragma unroll
    for (int a = 0; a < 2; ++a)
#pragma unroll
        for (int b = 0; b < 2; ++b)
#pragma unroll
            for (int m = 0; m < 4; ++m)
#pragma unroll
                for (int n = 0; n < 2; ++n) acc[a][b][m][n] = (f32x4){0.f, 0.f, 0.f, 0.f};
    bf16x8 At[4][2], B0[2][2], B1[2][2];
    const char* cA = (const char*)g.A + (size_t)cur.pm * tstep; const char* cB = (const char*)g.Bt + (size_t)cur.pn * tstep;
    S.a_ready(cur);
    if constexpr (SP2) {
        PG8_STAGE(PG8_SB(0, 0), cB, voffB); PG8_STAGE(PG8_SB(0, 1), cB + hstep, voffB); PG8_STAGE(PG8_SA(0, 0), cA, voffA); PG8_STAGE(PG8_SA(0, 1), cA + hstep, voffA);
        if (wr == 1) PG8_BAR;
        PG8_WAIT_V(2); PG8_BAR;
        PG8_STAGE(PG8_SB(1, 0), cB + kstep, voffB); PG8_STAGE(PG8_SA(1, 0), cA + kstep, voffA); PG8_STAGE(PG8_SB(1, 1), cB + hstep + kstep, voffB);
        PG8_WAIT_V(6); PG8_BAR;
    } else {
        PG8_STAGE(PG8_SB(0, 0), cB, voffB); PG8_STAGE(PG8_SA(0, 0), cA, voffA); PG8_STAGE(PG8_SB(0, 1), cB + hstep, voffB); PG8_STAGE(PG8_SA(0, 1), cA + hstep, voffA);
        if (wr == 1) PG8_BAR;
        PG8_WAIT_V(4); PG8_BAR;
        PG8_STAGE(PG8_SB(1, 0), cB + kstep, voffB); PG8_STAGE(PG8_SA(1, 0), cA + kstep, voffA); PG8_STAGE(PG8_SB(1, 1), cB + hstep + kstep, voffB);
        PG8_WAIT_V(6); PG8_BAR;
    }
    for (;;) {
        const bool has_next = S.next(ui + 1, nxt);
        const char* nA = has_next ? (const char*)g.A + (size_t)nxt.pm * tstep : cA; const char* nB = has_next ? (const char*)g.Bt + (size_t)nxt.pn * tstep : cB;
        for (int t = 0; t < nt; t += 2) {
            const bool last = (t == nt - 2);
            const char* a1 = cA + (size_t)(t + 1) * kstep;
            const char* a2 = last ? nA : cA + (size_t)(t + 2) * kstep; const char* b2 = last ? nB : cB + (size_t)(t + 2) * kstep;
            const char* a3 = a2 + kstep; const char* b3 = b2 + kstep;
            if (last && has_next) S.a_ready(nxt);
            if constexpr (SP2) {
            PG8_LDB(B0, 0, 0); PG8_LDB(B1, 0, 1); PG8_SCHED; PG8_LDA(At, 0, 0); PG8_STAGE(PG8_SA(1, 1), a1 + hstep, voffA);
            PG8_WAIT_V(8); PG8_WAIT_L(0); PG8_BAR; PG8_MMA(0, 0, At, B0); PG8_MMA(0, 1, At, B1); PG8_BAR; PG8_SCHED;
            PG8_LDA(At, 0, 1); PG8_STAGE(PG8_SB(0, 0), b2, voffB); PG8_STAGE(PG8_SB(0, 1), b2 + hstep, voffB); PG8_STAGE(PG8_SA(0, 0), a2, voffA);
            PG8_WAIT_V(8); PG8_WAIT_L(0); PG8_BAR; PG8_MMA(1, 0, At, B0); PG8_MMA(1, 1, At, B1); PG8_BAR; PG8_SCHED;
            PG8_LDB(B0, 1, 0); PG8_LDB(B1, 1, 1); PG8_SCHED; PG8_LDA(At, 1, 0); PG8_STAGE(PG8_SA(0, 1), a2 + hstep, voffA);
            PG8_WAIT_V(8); PG8_WAIT_L(0); PG8_BAR; PG8_MMA(0, 0, At, B0); PG8_MMA(0, 1, At, B1); PG8_BAR; PG8_SCHED;
            PG8_LDA(At, 1, 1); PG8_STAGE(PG8_SB(1, 0), b3, voffB); PG8_STAGE(PG8_SB(1, 1), b3 + hstep, voffB); PG8_STAGE(PG8_SA(1, 0), a3, voffA);
            PG8_WAIT_V(8); PG8_WAIT_L(0); PG8_BAR; PG8_MMA(1, 0, At, B0); PG8_MMA(1, 1, At, B1); PG8_BAR; PG8_SCHED;
            } else {
            PG8_LDB(B0, 0, 0); PG8_SCHED; PG8_LDA(At, 0, 0); PG8_STAGE(PG8_SA(1, 1), a1 + hstep, voffA);
            PG8_WAIT_L(8); PG8_BAR; PG8_WAIT_L(0); PG8_MMA(0, 0, At, B0); PG8_BAR; PG8_SCHED;
            PG8_LDB(B1, 0, 1); PG8_STAGE(PG8_SB(0, 0), b2, voffB);
            PG8_BAR; PG8_WAIT_L(0); PG8_MMA(0, 1, At, B1); PG8_BAR;
            PG8_LDA(At, 0, 1); PG8_STAGE(PG8_SA(0, 0), a2, voffA);
            PG8_BAR; PG8_WAIT_L(0); PG8_MMA(1, 0, At, B0); PG8_BAR; PG8_SCHED;
            PG8_STAGE(PG8_SB(0, 1), b2 + hstep, voffB);
            PG8_WAIT_V(6); PG8_BAR; PG8_MMA(1, 1, At, B1); PG8_BAR;
            PG8_LDB(B0, 1, 0); PG8_SCHED; PG8_LDA(At, 1, 0); PG8_STAGE(PG8_SA(0, 1), a2 + hstep, voffA);
            PG8_WAIT_L(8); PG8_BAR; PG8_WAIT_L(0); PG8_MMA(0, 0, At, B0); PG8_BAR; PG8_SCHED;
            PG8_LDB(B1, 1, 1); PG8_STAGE(PG8_SB(1, 0), b3, voffB);
            PG8_BAR; PG8_WAIT_L(0); PG8_MMA(0, 1, At, B1); PG8_BAR;
            PG8_LDA(At, 1, 1); PG8_STAGE(PG8_SA(1, 0), a3, voffA);
            PG8_BAR; PG8_WAIT_L(0); PG8_MMA(1, 0, At, B0); PG8_BAR; PG8_SCHED;
            PG8_STAGE(PG8_SB(1, 1), b3 + hstep, voffB);
            PG8_WAIT_V(6); PG8_BAR; PG8_MMA(1, 1, At, B1); PG8_BAR;
            }
        }
        if constexpr (ALIGN_EPI) { if (wr == 0) PG8_BAR; }
        if constexpr (!Epi::AFTER_DRAIN) { E(acc, cur, wr, wc, fr, fq); S.done(cur); }
        if (!has_next) break;
#pragma unroll
        for (int a = 0; a < 2; ++a)
#pragma unroll
            for (int b = 0; b < 2; ++b)
#pragma unroll
                for (int m = 0; m < 4; ++m)
#pragma unroll
                    for (int n = 0; n < 2; ++n) acc[a][b][m][n] = (f32x4){0.f, 0.f, 0.f, 0.f};
        cur = nxt; cA = nA; cB = nB; ++ui;
        if constexpr (ALIGN_EPI) { if (wr == 1) PG8_BAR; }
    }
    PG8_WAIT_V(0);
    if constexpr (!ALIGN_EPI) { if (wr == 0) PG8_BAR; }
    PG8_BAR;
    if constexpr (Epi::AFTER_DRAIN) { E.fused(acc, cur, wr, wc, fr, fq, lds, wid, lane); S.done(cur); }
#undef PG8_SA
#undef PG8_SB
#undef PG8_STAGE
#undef PG8_LDA
#undef PG8_LDB
#undef PG8_MMA
#undef PG8_WAIT_V
#undef PG8_WAIT_L
#undef PG8_BAR
#undef PG8_SCHED
}
}

constexpr int DM = 2048, SEQ = 8192, CTX = 256, MROWS = SEQ + CTX, INW = 2560, DFF = 8192, NMOD = 6 * DM;
constexpr float EPS = 1e-6f;
constexpr int NWAVES = 8, NTHR = 512;
constexpr size_t MiB = 1u << 20;
constexpr size_t WS_CTL = 0, CTL_ZERO_BYTES = 128 * 1024;
constexpr size_t OFF_MOD = 0, OFF_CMOD = 64 * 1024;
constexpr size_t OFF_ROPE = 512 * 1024;
constexpr size_t WS_WIN = 1 * MiB, WS_WOUT = 11 * MiB, WS_WUP = 19 * MiB, WS_WDN = 51 * MiB;
constexpr size_t WS_H = 83 * MiB;
constexpr size_t WS_X1 = 116 * MiB;
constexpr size_t WS_ACT = 180 * MiB;
constexpr size_t WS_P = 180 * MiB;
constexpr size_t WS_MIX = 222 * MiB;
constexpr size_t WS_END = 308 * MiB;
static_assert(WS_P + (size_t)MROWS * INW * 2 <= WS_MIX && WS_MIX + (size_t)SEQ * DM * 2 <= WS_END && WS_H + (size_t)MROWS * DM * 2 <= WS_X1, "d_ws map");

#define LAS __attribute__((address_space(3)))
typedef unsigned short bf16;
typedef unsigned v4u __attribute__((ext_vector_type(4)));
typedef unsigned v2u __attribute__((ext_vector_type(2)));
typedef float f32x4 __attribute__((ext_vector_type(4)));
typedef float f32x16 __attribute__((ext_vector_type(16)));
typedef short bf16x8 __attribute__((ext_vector_type(8)));
typedef short s16x4 __attribute__((ext_vector_type(4)));
#define LDS_WAIT() asm volatile("s_waitcnt lgkmcnt(0)" ::: "memory")
__device__ __forceinline__ unsigned pk2(float lo, float hi) { return pg8::cvt_pk_bf16(lo, hi); }
__device__ __forceinline__ float bf2f(unsigned short b) { return __uint_as_float((unsigned)b << 16); }
__device__ __forceinline__ float wave_sum(float v) {
#pragma unroll
    for (int o = 1; o < 64; o <<= 1) v += __shfl_xor(v, o);
    return v;
}
__device__ __forceinline__ float rl(float v, int l) { return __uint_as_float(__builtin_amdgcn_readlane(__float_as_uint(v), l)); }

__device__ __forceinline__ void transpose_item(const float* W, int ldw, int ncol0, int nblk, int K, bf16* WT, LAS float* scr, int item, int lane) {
    const int kb = item / nblk, nb = item % nblk, k0 = 64 * kb, n0 = 32 * nb;
#pragma unroll 8
    for (int i = 0; i < 32; ++i) { const int kk = 2 * i + (lane >> 5); scr[kk * 33 + (lane & 31)] = W[(size_t)(k0 + kk) * ldw + ncol0 + n0 + (lane & 31)]; }
    LDS_WAIT(); asm volatile("" ::: "memory");
    const int c = lane & 7;
#pragma unroll
    for (int j = 0; j < 4; ++j) { const int n = (lane >> 3) + 8 * j; const LAS float* s = scr + (8 * c) * 33 + n;
        v4u o; o.x = pk2(s[0 * 33], s[1 * 33]); o.y = pk2(s[2 * 33], s[3 * 33]); o.z = pk2(s[4 * 33], s[5 * 33]); o.w = pk2(s[6 * 33], s[7 * 33]);
        *(v4u*)(WT + (size_t)(n0 + n) * K + k0 + 8 * c) = o; }
    LDS_WAIT(); asm volatile("" ::: "memory");
}
__device__ __forceinline__ void fold_item(const float* w_in, const float* pool_w, const float* pool_scale, bf16* Win_t, int item, int lane) {
    const int g = item >> 10, kb = (item >> 2) & 255, dq = item & 3, k0 = kb * 8, d = dq * 64 + lane;
    float wreg[8][4];
#pragma unroll
    for (int kk = 0; kk < 8; ++kk)
#pragma unroll
        for (int j = 0; j < 4; ++j) wreg[kk][j] = w_in[(size_t)(k0 + kk) * INW + 1536 + g * 256 + j * 64 + lane];
    float acc[8];
#pragma unroll
    for (int kk = 0; kk < 8; ++kk) acc[kk] = 0.f;
    const float* pw = pool_w + (size_t)g * 65536 + d;
#pragma unroll
    for (int j = 0; j < 4; ++j) {
#pragma unroll 4
        for (int cc = 0; cc < 64; ++cc) { const float p = pw[(size_t)(j * 64 + cc) * 256];
#pragma unroll
            for (int kk = 0; kk < 8; ++kk) acc[kk] = fmaf(rl(wreg[kk][j], cc), p, acc[kk]); }
    }
    const float sc = pool_scale[g * 256 + d];
    v4u o; o.x = pk2(acc[0] * sc, acc[1] * sc); o.y = pk2(acc[2] * sc, acc[3] * sc); o.z = pk2(acc[4] * sc, acc[5] * sc); o.w = pk2(acc[6] * sc, acc[7] * sc);
    *(v4u*)(Win_t + (size_t)(1536 + g * 256 + d) * DM + k0) = o;
}
__device__ __forceinline__ float silu(float v) { return v / (1.f + __expf(-v)); }
__device__ __forceinline__ void ada_item(const float* c, const float* cctx, const float* w_ada, const float* b_ada, float* mod, float* cmod, int item, int lane) {
    const int kc = item / 48, nb = item % 48, k0 = kc * 64, n0 = nb * 256 + 4 * lane;
    const float s = silu(c[k0 + lane]), sx = silu(cctx[k0 + lane]);
    f32x4 a = (f32x4){0.f, 0.f, 0.f, 0.f}, ax = a;
    const bool dox = nb < 16;
    const float* wp = w_ada + (size_t)k0 * NMOD + n0;
#pragma unroll 8
    for (int kk = 0; kk < 64; ++kk) { const f32x4 w = *(const f32x4*)(wp + (size_t)kk * NMOD); a += w * rl(s, kk); ax += w * rl(sx, kk); }
    if (kc == 0) { const f32x4 b = *(const f32x4*)(b_ada + n0); a += b; ax += b; }
#pragma unroll
    for (int j = 0; j < 4; ++j) __hip_atomic_fetch_add(mod + n0 + j, a[j], __ATOMIC_RELAXED, __HIP_MEMORY_SCOPE_AGENT);
    if (dox) {
#pragma unroll
        for (int j = 0; j < 4; ++j) __hip_atomic_fetch_add(cmod + n0 + j, ax[j], __ATOMIC_RELAXED, __HIP_MEMORY_SCOPE_AGENT);
    }
}
__device__ __forceinline__ void rope_entry(float* rope, int idx) {
    const int pos = idx >> 4, i = idx & 15;
    const float inv = (float)exp2(-(double)i * (13.287712379549449 / 16.0));
    const float angf = (float)pos * inv;
    const double TWO_PI = 6.283185307179586476925;
    double r = (double)angf; r -= TWO_PI * rint(r / TWO_PI);
    const double r2 = r * r; double sterm = r, cterm = 1.0, sn = r, cs = 1.0;
    for (int n = 1; n <= 15; ++n) { cterm *= -r2 / (double)((2 * n - 1) * (2 * n)); sterm *= -r2 / (double)((2 * n) * (2 * n + 1)); cs += cterm; sn += sterm; }
    rope[idx] = (float)cs; rope[2048 + idx] = (float)sn;
}
__device__ __forceinline__ void norm_mod_row(const float* xrow, bf16* orow, const f32x4 (&ab)[8], const f32x4 (&sb)[8], int lane) {
    const f32x4* xr = (const f32x4*)xrow + lane;
    f32x4 v[8]; float ss = 0.f;
#pragma unroll
    for (int j = 0; j < 8; ++j) { v[j] = xr[64 * j]; ss += (v[j].x * v[j].x + v[j].y * v[j].y) + (v[j].z * v[j].z + v[j].w * v[j].w); }
    const float rstd = 1.0f / sqrtf(wave_sum(ss) * (1.f / DM) + EPS);
    v2u* o8 = (v2u*)orow + lane;
#pragma unroll
    for (int j = 0; j < 8; ++j) { const f32x4 y = v[j] * rstd * ab[j] + sb[j]; v2u w; w.x = pk2(y.x, y.y); w.y = pk2(y.z, y.w); o8[64 * j] = w; }
}
__device__ __forceinline__ void norm_mod_pass(const float* X, int row_lo, int row_hi, bf16* Hrows, const float* nw, const float* shift, const float* scale, int gw, int NGW, int lane) {
    f32x4 ab[8], sb[8];
#pragma unroll
    for (int j = 0; j < 8; ++j) { const int cidx = 4 * lane + 256 * j; const f32x4 w = *(const f32x4*)(nw + cidx), sc = *(const f32x4*)(scale + cidx); ab[j] = w * (sc + 1.0f); sb[j] = *(const f32x4*)(shift + cidx); }
    for (int m = row_lo + gw; m < row_hi; m += NGW) norm_mod_row(X + (size_t)(m - row_lo) * DM, Hrows + (size_t)m * DM, ab, sb, lane);
}

namespace att {
constexpr int KS = 144, VS = 192;
constexpr int KBUF = 64 * KS, VBUF = 64 * VS;
constexpr int OFF_K = 0, OFF_V = 2 * KBUF;
constexpr float LOG2E = 1.4426950408889634f;
typedef short v4i16_t __attribute__((ext_vector_type(4)));
__device__ __forceinline__ s16x4 vtr(LAS unsigned char* p) { return __builtin_bit_cast(s16x4, __builtin_amdgcn_ds_read_tr16_b64_v4i16((LAS v4i16_t*)p)); }
__device__ __forceinline__ int tile_row0(int t, int b) { return t < 4 ? SEQ + 64 * t : 128 * b - 128 + 64 * (t - 4); }
__device__ __forceinline__ void attn_unit(LAS unsigned char* lds, const bf16* P, bf16* MIX, const float* sink, int b, int h) {
    const int tid = threadIdx.x, lane = tid & 63, r32 = lane & 31, hi = lane >> 5, wid = __builtin_amdgcn_readfirstlane(tid >> 6);
    const int head = 4 * h + (wid & 3), q0 = 128 * b + 64 * (wid >> 2);
    bf16x8 qf[2][4];
#pragma unroll
    for (int qb = 0; qb < 2; ++qb)
#pragma unroll
        for (int d0 = 0; d0 < 4; ++d0) qf[qb][d0] = *(const bf16x8*)(P + (size_t)(q0 + 32 * qb + r32) * INW + head * 64 + d0 * 16 + hi * 8);
    float mrun[2], lrun[2]; f32x16 o[2][2];
    const float sk = sink[head] * LOG2E;
#pragma unroll
    for (int qb = 0; qb < 2; ++qb) { mrun[qb] = sk; lrun[qb] = hi == 0 ? 1.f : 0.f;
#pragma unroll
        for (int db = 0; db < 2; ++db)
#pragma unroll
            for (int r = 0; r < 16; ++r) o[db][qb][r] = 0.f; }
    const int srow = tid >> 3, sch = tid & 7;
    const bf16* kbase = P + 1024 + h * 64 + sch * 8; const bf16* vbase = P + 1280 + h * 64 + sch * 8;
    const int tend = (b == 63) ? 8 : 10;
    v4u kreg, vreg;
    { const size_t ro = (size_t)(tile_row0(0, b) + srow) * INW; kreg = *(const v4u*)(kbase + ro); vreg = *(const v4u*)(vbase + ro); }
    *(LAS v4u*)(lds + OFF_K + srow * KS + sch * 16) = kreg; *(LAS v4u*)(lds + OFF_V + srow * VS + sch * 16) = vreg;
    __syncthreads();
    const int kread = r32 * KS + hi * 16;
    const int vread = (((lane & 15) >> 2) + 4 * hi) * VS + (16 * ((lane >> 4) & 1) + 4 * (lane & 3)) * 2;
    int t = 0, buf = 0;
    for (;;) {
        int tn = t + 1; if (b == 0 && tn == 4) tn = 6;
        const bool has = tn < tend;
        if (has) { const size_t ro = (size_t)(tile_row0(tn, b) + srow) * INW; kreg = *(const v4u*)(kbase + ro); vreg = *(const v4u*)(vbase + ro); }
        int dt = 0; bool act = true;
        if (t >= 4) { const int k0 = 128 * b - 128 + 64 * (t - 4); dt = (k0 - q0) / 64; act = (dt >= -2 && dt <= 2); }
        if (act) {
            LAS unsigned char* Kb = lds + OFF_K + buf * KBUF; LAS unsigned char* Vb = lds + OFF_V + buf * VBUF;
            f32x16 p[2][2];
#pragma unroll
            for (int kb = 0; kb < 2; ++kb)
#pragma unroll
                for (int qb = 0; qb < 2; ++qb)
#pragma unroll
                    for (int r = 0; r < 16; ++r) p[kb][qb][r] = 0.f;
#pragma unroll
            for (int kb = 0; kb < 2; ++kb)
#pragma unroll
                for (int d0 = 0; d0 < 4; ++d0) { const bf16x8 kf = *(const LAS bf16x8*)(Kb + kread + kb * 32 * KS + d0 * 32);
#pragma unroll
                    for (int qb = 0; qb < 2; ++qb) p[kb][qb] = __builtin_amdgcn_mfma_f32_32x32x16_bf16(kf, qf[qb][d0], p[kb][qb], 0, 0, 0); }
            if (dt == 2 || dt == -2) {
#pragma unroll
                for (int kb = 0; kb < 2; ++kb)
#pragma unroll
                    for (int qb = 0; qb < 2; ++qb)
#pragma unroll
                        for (int r = 0; r < 16; ++r) { const int dkq = 64 * dt + 32 * kb + (r & 3) + 8 * (r >> 2) + 4 * hi - (32 * qb + r32);
                            if (dkq > 128 || dkq < -128) p[kb][qb][r] = -1e30f; }
            }
#pragma unroll
            for (int qb = 0; qb < 2; ++qb) {
                float mx = p[0][qb][0];
#pragma unroll
                for (int kb = 0; kb < 2; ++kb)
#pragma unroll
                    for (int r = 0; r < 16; ++r) mx = fmaxf(mx, p[kb][qb][r]);
                mx = fmaxf(mx, __shfl_xor(mx, 32));
                const float mn = fmaxf(mrun[qb], mx), alpha = __builtin_amdgcn_exp2f(mrun[qb] - mn); mrun[qb] = mn;
                float s = 0.f;
#pragma unroll
                for (int kb = 0; kb < 2; ++kb)
#pragma unroll
                    for (int r = 0; r < 16; ++r) { const float e = __builtin_amdgcn_exp2f(p[kb][qb][r] - mn); p[kb][qb][r] = e; s += e; }
                lrun[qb] = lrun[qb] * alpha + s;
#pragma unroll
                for (int db = 0; db < 2; ++db)
#pragma unroll
                    for (int r = 0; r < 16; ++r) o[db][qb][r] *= alpha;
            }
#pragma unroll
            for (int kb = 0; kb < 2; ++kb)
#pragma unroll
                for (int s2 = 0; s2 < 2; ++s2) {
                    bf16x8 pb[2];
#pragma unroll
                    for (int qb = 0; qb < 2; ++qb) { v4u w; w.x = pk2(p[kb][qb][8 * s2 + 0], p[kb][qb][8 * s2 + 1]); w.y = pk2(p[kb][qb][8 * s2 + 2], p[kb][qb][8 * s2 + 3]);
                        w.z = pk2(p[kb][qb][8 * s2 + 4], p[kb][qb][8 * s2 + 5]); w.w = pk2(p[kb][qb][8 * s2 + 6], p[kb][qb][8 * s2 + 7]); pb[qb] = __builtin_bit_cast(bf16x8, w); }
#pragma unroll
                    for (int db = 0; db < 2; ++db) {
                        LAS unsigned char* vp = Vb + vread + (32 * kb + 16 * s2) * VS + 64 * db;
                        const s16x4 lo = vtr(vp), hi4 = vtr(vp + 8 * VS);
                        const bf16x8 vf = (bf16x8){lo[0], lo[1], lo[2], lo[3], hi4[0], hi4[1], hi4[2], hi4[3]};
#pragma unroll
                        for (int qb = 0; qb < 2; ++qb) o[db][qb] = __builtin_amdgcn_mfma_f32_32x32x16_bf16(vf, pb[qb], o[db][qb], 0, 0, 0);
                    }
                }
        }
        if (has) { *(LAS v4u*)(lds + OFF_K + (buf ^ 1) * KBUF + srow * KS + sch * 16) = kreg; *(LAS v4u*)(lds + OFF_V + (buf ^ 1) * VBUF + srow * VS + sch * 16) = vreg; }
        __syncthreads();
        if (!has) break;
        t = tn; buf ^= 1;
    }
#pragma unroll
    for (int qb = 0; qb < 2; ++qb) {
        const float lt = lrun[qb] + __shfl_xor(lrun[qb], 32), inv = 1.0f / lt;
        bf16* orow = MIX + (size_t)(q0 + 32 * qb + r32) * DM + head * 64 + 4 * hi;
#pragma unroll
        for (int db = 0; db < 2; ++db)
#pragma unroll
            for (int a = 0; a < 4; ++a) { v2u w; w.x = pk2(o[db][qb][4 * a] * inv, o[db][qb][4 * a + 1] * inv); w.y = pk2(o[db][qb][4 * a + 2] * inv, o[db][qb][4 * a + 3] * inv);
                *(v2u*)(orow + 32 * db + 8 * a) = w; }
    }
}
}

__device__ __forceinline__ void pool_item(const bf16* P, bf16* MIX, int idx) {
    const int t = idx >> 7, ch = idx & 127, g = ch >> 5, w = 2 << g;
    int lo = t - (w >> 1), hi = lo + w; lo = lo < 0 ? 0 : lo; hi = hi > SEQ ? SEQ : hi;
    const bf16* up = P + 1536 + ch * 8;
    float s[8];
#pragma unroll
    for (int e = 0; e < 8; ++e) s[e] = 0.f;
    for (int tt = lo; tt < hi; ++tt) { const v4u v = *(const v4u*)(up + (size_t)tt * INW);
        s[0] += __uint_as_float(v.x << 16); s[1] += __uint_as_float(v.x & 0xffff0000u); s[2] += __uint_as_float(v.y << 16); s[3] += __uint_as_float(v.y & 0xffff0000u);
        s[4] += __uint_as_float(v.z << 16); s[5] += __uint_as_float(v.z & 0xffff0000u); s[6] += __uint_as_float(v.w << 16); s[7] += __uint_as_float(v.w & 0xffff0000u); }
    const v4u c = *(const v4u*)(up + (size_t)t * INW);
    const float inv = 1.0f / (float)(hi - lo);
    float ce[8] = {__uint_as_float(c.x << 16), __uint_as_float(c.x & 0xffff0000u), __uint_as_float(c.y << 16), __uint_as_float(c.y & 0xffff0000u),
                   __uint_as_float(c.z << 16), __uint_as_float(c.z & 0xffff0000u), __uint_as_float(c.w << 16), __uint_as_float(c.w & 0xffff0000u)};
    v4u o; o.x = pk2(s[0] * inv - ce[0], s[1] * inv - ce[1]); o.y = pk2(s[2] * inv - ce[2], s[3] * inv - ce[3]); o.z = pk2(s[4] * inv - ce[4], s[5] * inv - ce[5]); o.w = pk2(s[6] * inv - ce[6], s[7] * inv - ce[7]);
    *(v4u*)(MIX + (size_t)t * DM + 1024 + ch * 8) = o;
}

constexpr int LDS_BYTES = 147456;
constexpr int NPHASE = 9;
struct Args { const float* in[16]; float* out; unsigned char* ws; int ph_lo, ph_hi; };
__global__ void __launch_bounds__(NTHR, 2) fwd_megakernel(Args args) {
    extern __shared__ __attribute__((aligned(16))) unsigned char lds_raw[];
    cg::grid_group grid = cg::this_grid();
    LAS unsigned char* lds = (LAS unsigned char*)lds_raw;
    const int tid = threadIdx.x, lane = tid & 63, wave = __builtin_amdgcn_readfirstlane(tid >> 6);
    const int G = gridDim.x, bx = blockIdx.x;
    const int gw = bx * NWAVES + wave, NGW = G * NWAVES;
    const float *x = args.in[0], *cvec = args.in[1], *ctx = args.in[2], *cctx = args.in[3], *norm_attn_w = args.in[4], *norm_mlp_w = args.in[5], *w_ada = args.in[6], *b_ada = args.in[7],
                *w_in = args.in[8], *attn_sink = args.in[9], *pool_w = args.in[10], *pool_scale = args.in[11], *w_out = args.in[12], *w_up = args.in[13], *w_dn = args.in[14], *final_w = args.in[15];
    unsigned char* ws = args.ws;
    float* mod = (float*)(ws + OFF_MOD); float* cmod = (float*)(ws + OFF_CMOD); float* rope = (float*)(ws + OFF_ROPE);
    bf16 *Win_t = (bf16*)(ws + WS_WIN), *Wout_t = (bf16*)(ws + WS_WOUT), *Wup_t = (bf16*)(ws + WS_WUP), *Wdn_t = (bf16*)(ws + WS_WDN);
    bf16 *H = (bf16*)(ws + WS_H), *P = (bf16*)(ws + WS_P), *MIX = (bf16*)(ws + WS_MIX), *ACT = (bf16*)(ws + WS_ACT);
    float* X1 = (float*)(ws + WS_X1);
    const int lo = args.ph_lo, hi = args.ph_hi;
#define IN(k) (lo <= (k) && (k) < hi)
#define SEAM(k) do { if (IN(k) && IN((k) + 1)) grid.sync(); } while (0)

    if (IN(0)) {
        LAS float* scr = (LAS float*)(lds + wave * 16384);
        constexpr int I_IN = 32 * 48, I_OUT = 32 * 64, I_UP = 32 * 256, I_DN = 128 * 64, I_FOLD = 4096, I_ADA = 32 * 48;
        constexpr int NITEMS = I_ADA + I_FOLD + I_IN + I_OUT + I_UP + I_DN;
        for (int it = gw; it < NITEMS; it += NGW) {
            int r = it;
            if (r < I_ADA) { ada_item(cvec, cctx, w_ada, b_ada, mod, cmod, r, lane); continue; } r -= I_ADA;
            if (r < I_FOLD) { fold_item(w_in, pool_w, pool_scale, Win_t, r, lane); continue; } r -= I_FOLD;
            if (r < I_IN) { transpose_item(w_in, INW, 0, 48, DM, Win_t, scr, r, lane); continue; } r -= I_IN;
            if (r < I_OUT) { transpose_item(w_out, DM, 0, 64, DM, Wout_t, scr, r, lane); continue; } r -= I_OUT;
            if (r < I_UP) { transpose_item(w_up, DFF, 0, 256, DM, Wup_t, scr, r, lane); continue; } r -= I_UP;
            transpose_item(w_dn, DM, 0, 64, DFF, Wdn_t, scr, r, lane);
        }
        for (int idx = bx * NTHR + tid; idx < 2048; idx += G * NTHR) rope_entry(rope, idx);
    }
    SEAM(0);
    if (IN(1)) {
        norm_mod_pass(x, 0, SEQ, H, norm_attn_w, mod, mod + DM, gw, NGW, lane);
        norm_mod_pass(ctx, SEQ, MROWS, H, norm_attn_w, cmod, cmod + DM, gw, NGW, lane);
    }
    SEAM(1);
    if (IN(2)) {
        pg8::Gemm g{H, Win_t, MROWS, INW, DM}; pg8::InProjOrder S; S.init(G, bx);
        pg8::EpiInProj E{P, rope};
        pg8::gemm_phase<pg8::EpiInProj, pg8::InProjOrder, true, true>(lds, g, S, E);
    }
    SEAM(2);
    if (IN(3)) {
        for (int u = bx; u < 256; u += G) att::attn_unit(lds, P, MIX, attn_sink, u >> 2, u & 3);
        for (int idx = bx * NTHR + tid; idx < SEQ * 128; idx += G * NTHR) pool_item(P, MIX, idx);
    }
    SEAM(3);
    if (IN(4)) {
        pg8::Gemm g{MIX, Wout_t, SEQ, DM, DM}; pg8::StaticOrder S; S.init(SEQ, DM, G, bx);
        pg8::EpiResGate E{x, X1, mod + 2 * DM, DM};
        pg8::gemm_phase<pg8::EpiResGate, pg8::StaticOrder, true, true>(lds, g, S, E);
    }
    SEAM(4);
    if (IN(5)) norm_mod_pass(X1, 0, SEQ, H, norm_mlp_w, mod + 3 * DM, mod + 4 * DM, gw, NGW, lane);
    SEAM(5);
    if (IN(6)) {
        pg8::Gemm g{H, Wup_t, SEQ, DFF, DM}; pg8::StaticOrder S; S.init(SEQ, DFF, G, bx);
        pg8::EpiRelu2 E{ACT, DFF};
        pg8::gemm_phase<pg8::EpiRelu2, pg8::StaticOrder, true, true>(lds, g, S, E);
    }
    SEAM(6);
    if (IN(7)) {
        pg8::Gemm g{ACT, Wdn_t, SEQ, DM, DFF}; pg8::StaticOrder S; S.init(SEQ, DM, G, bx);
        pg8::EpiResGate E{X1, X1, mod + 5 * DM, DM};
        pg8::gemm_phase<pg8::EpiResGate, pg8::StaticOrder, true, true>(lds, g, S, E);
    }
    SEAM(7);
    if (IN(8)) {
        f32x4 wv[8];
#pragma unroll
        for (int j = 0; j < 8; ++j) wv[j] = *(const f32x4*)(final_w + 4 * lane + 256 * j);
        for (int m = gw; m < SEQ; m += NGW) {
            const f32x4* xr = (const f32x4*)(X1 + (size_t)m * DM) + lane; f32x4 v[8]; float ss = 0.f;
#pragma unroll
            for (int j = 0; j < 8; ++j) { v[j] = xr[64 * j]; ss += (v[j].x * v[j].x + v[j].y * v[j].y) + (v[j].z * v[j].z + v[j].w * v[j].w); }
            const float rstd = 1.0f / sqrtf(wave_sum(ss) * (1.f / DM) + EPS);
            f32x4* orow = (f32x4*)(args.out + (size_t)m * DM) + lane;
#pragma unroll
            for (int j = 0; j < 8; ++j) orow[64 * j] = v[j] * rstd * wv[j];
        }
    }
#undef IN
#undef SEAM
}

extern "C" void kernel_launch(void* const* d_in, const int* in_sizes, int n_in, void* d_out, int out_size, void* d_ws, size_t ws_size, hipStream_t stream) {
    static int grid = 0;
    if (grid == 0) {
        if (n_in != 16 || out_size != SEQ * DM || ws_size < WS_END) { fprintf(stderr, "kernel_launch: unexpected shapes (n_in %d out %d ws %zu)\n", n_in, out_size, ws_size); grid = -1; return; }
        int dev = 0, cus = 0, per_cu = 0;
        hipGetDevice(&dev); hipDeviceGetAttribute(&cus, hipDeviceAttributeMultiprocessorCount, dev);
        if (hipFuncSetAttribute((const void*)fwd_megakernel, hipFuncAttributeMaxDynamicSharedMemorySize, LDS_BYTES) != hipSuccess) { fprintf(stderr, "kernel_launch: hipFuncSetAttribute failed\n"); grid = -1; return; }
        if (hipOccupancyMaxActiveBlocksPerMultiprocessor(&per_cu, (const void*)fwd_megakernel, NTHR, LDS_BYTES) != hipSuccess || per_cu < 1) { fprintf(stderr, "kernel_launch: occupancy query says %d\n", per_cu); per_cu = 1; }
        (void)hipGetLastError();
        grid = cus;
        fprintf(stderr, "kernel_launch: grid %d (cus %d, per_cu %d)\n", grid, cus, per_cu);
    }
    if (grid < 0) return;
    hipMemsetAsync((char*)d_ws + WS_CTL, 0, CTL_ZERO_BYTES, stream);
    Args a{};
    for (int i = 0; i < 16; ++i) a.in[i] = (const float*)d_in[i];
    a.out = (float*)d_out; a.ws = (unsigned char*)d_ws;
    for (int li = 0; li < NL; ++li) {
        a.ph_lo = (NL == 1) ? 0 : li; a.ph_hi = (NL == 1) ? NPHASE : li + 1;
        void* kargs[] = {&a};
        hipError_t e = hipLaunchCooperativeKernel((const void*)fwd_megakernel, dim3(grid), dim3(NTHR), kargs, LDS_BYTES, stream);
        if (e != hipSuccess) { fprintf(stderr, "kernel_launch: cooperative launch failed: %s\n", hipGetErrorString(e)); break; }
    }
}
```

```cpp
#include <hip/hip_runtime.h>
#include <hip/hip_cooperative_groups.h>
#include <cstdio>
#include <cstdint>
namespace cg = cooperative_groups;
#ifndef NL
#define NL 1
#endif
#define PROBE_SYNC 0
#define PROBE_P0 0
#define PROBE_P3 0
#define PROBE_POOL 0
namespace pg8 {
#define PG8_LAS __attribute__((address_space(3)))
typedef unsigned short bf16_t;
typedef short bf16x8 __attribute__((ext_vector_type(8)));
typedef float f32x4 __attribute__((ext_vector_type(4)));
typedef unsigned u32x4 __attribute__((ext_vector_type(4)));
constexpr int BM = 256, BK = 64, HALF = 128, HTB = HALF * BK * 2  , STAGE_BYTES = 8 * HTB, NXCD = 8, WGM = 8;

__host__ __device__ __forceinline__ int lds_byte(int r, int c) { const int st = (r >> 4) * 2 + (c >> 5), rr = r & 15, cc = c & 31, ob = rr * 64 + cc * 2; return st * 1024 + (ob ^ (((ob >> 9) & 1) << 5)); }
__host__ __device__ __forceinline__ void stage_rc(int b, int& R, int& C) { const int st = b / 1024, sb = b % 1024, swz = sb ^ (((sb >> 9) & 1) << 5); R = (st >> 1) * 16 + swz / 64; C = (st & 1) * 32 + (swz % 64) / 2; }
__host__ __device__ __forceinline__ int perm32(int rho) { const int n = rho >> 4, i = rho & 15; return 8 * (i >> 2) + 4 * n + (i & 3); }

struct Unit { int pm, pn; };
struct Gemm { const bf16_t* A; const bf16_t* Bt; int M, N, K; };

struct StaticOrder {
    int nM, nN, nwg, G, c;
    __host__ __device__ void init(int M, int N, int G_, int c_) { nM = M / BM; nN = N / BM; nwg = nM * nN; G = G_; c = c_; }
    __host__ __device__ bool next(int i, Unit& u) const {
        const long L = (long)i * G + c; if (L >= nwg) return false;
        int wgid = (int)L; { const int q = nwg / NXCD, r = nwg % NXCD, xcd = wgid % NXCD, off = wgid / NXCD; wgid = (xcd < r ? xcd * (q + 1) : r * (q + 1) + (xcd - r) * q) + off; }
        const int nig = WGM * nN, gid = wgid / nig, fm = gid * WGM, gsz = (nM - fm) < WGM ? (nM - fm) : WGM;
        u.pm = fm + ((wgid % nig) % gsz); u.pn = (wgid % nig) / gsz; return true;
    }
    __device__ __forceinline__ void a_ready(const Unit&) const {}
    __device__ __forceinline__ void done(const Unit&) const {}
};
__device__ __forceinline__ unsigned cvt_pk_bf16(float lo, float hi) { unsigned r; asm volatile("v_cvt_pk_bf16_f32 %0, %1, %2" : "=v"(r) : "v"(lo), "v"(hi)); return r; }
typedef float f32x2 __attribute__((ext_vector_type(2)));
typedef unsigned u32x2 __attribute__((ext_vector_type(2)));
constexpr float QSCALE = 0.125f * 1.4426950408889634f;

struct InProjOrder {
    StaticOrder so;
    __device__ void init(int G_, int c_) { so.init(8192, 2560, G_, c_); }
    __device__ bool next(int i, Unit& u) const {
        const long L = (long)i * so.G + so.c;
        if (L < 320) return so.next(i, u);
        if (L < 322) { u.pm = 32; u.pn = 4 + (int)(L - 320); return true; }
        return false;
    }
    __device__ __forceinline__ void a_ready(const Unit&) const {}
    __device__ __forceinline__ void done(const Unit&) const {}
};

struct EpiInProj {
    static constexpr bool PERM = false, AFTER_DRAIN = false;
    bf16_t* O; const float* rope;
    __device__ __forceinline__ void operator()(const f32x4 (&acc)[2][2][4][2], const Unit& u, int wr, int wc, int fr, int fq) const {
        const bool dorope = (u.pm < 32) && (u.pn < 5);
        const float qs = (u.pn < 4) ? QSCALE : 1.f;
        const int col0 = u.pn * BM + wc * 32 + 4 * fq;
#pragma unroll
        for (int ai = 0; ai < 2; ++ai)
#pragma unroll
            for (int m = 0; m < 4; ++m) {
                const int r = u.pm * BM + ai * HALF + wr * 64 + m * 16 + fr;
                f32x4 cs = (f32x4){qs, qs, qs, qs}, sn = (f32x4){0.f, 0.f, 0.f, 0.f};
                if (dorope) { const int pos = (wc & 1) ? (r & 63) : (r >> 6);
                    cs = *(const f32x4*)(rope + pos * 16 + 4 * fq) * qs; sn = *(const f32x4*)(rope + 2048 + pos * 16 + 4 * fq) * qs; }
                bf16_t* rowp = O + (size_t)r * 2560 + col0;
#pragma unroll
                for (int bj = 0; bj < 2; ++bj) {
                    const f32x4 x1 = acc[ai][bj][m][0], x2 = acc[ai][bj][m][1];
                    const f32x4 o1 = x1 * cs - x2 * sn, o2 = x1 * sn + x2 * cs;
                    u32x2 w1, w2; w1.x = cvt_pk_bf16(o1[0], o1[1]); w1.y = cvt_pk_bf16(o1[2], o1[3]); w2.x = cvt_pk_bf16(o2[0], o2[1]); w2.y = cvt_pk_bf16(o2[2], o2[3]);
                    *(u32x2*)(rowp + bj * HALF) = w1; *(u32x2*)(rowp + bj * HALF + 16) = w2;
                }
            }
    }
};

struct EpiResGate {
    static constexpr bool PERM = false, AFTER_DRAIN = false;
    const float* base; float* out; const float* gate; int ldc;
    __device__ __forceinline__ void operator()(const f32x4 (&acc)[2][2][4][2], const Unit& u, int wr, int wc, int fr, int fq) const {
        const int col0 = u.pn * BM + wc * 32 + 4 * fq;
        f32x4 gv[2][2];
#pragma unroll
        for (int bj = 0; bj < 2; ++bj)
#pragma unroll
            for (int n = 0; n < 2; ++n) gv[bj][n] = *(const f32x4*)(gate + col0 + bj * HALF + n * 16);
#pragma unroll
        for (int ai = 0; ai < 2; ++ai)
#pragma unroll
            for (int m = 0; m < 4; ++m) {
                const size_t off = (size_t)(u.pm * BM + ai * HALF + wr * 64 + m * 16 + fr) * ldc + col0;
#pragma unroll
                for (int bj = 0; bj < 2; ++bj)
#pragma unroll
                    for (int n = 0; n < 2; ++n) { const f32x4 b = *(const f32x4*)(base + off + bj * HALF + n * 16); *(f32x4*)(out + off + bj * HALF + n * 16) = b + gv[bj][n] * acc[ai][bj][m][n]; }
                if (m & 1) asm volatile("" ::: "memory");
            }
    }
};

struct EpiRelu2 {
    static constexpr bool PERM = true, AFTER_DRAIN = false;
    bf16_t* O; int ldc;
    __device__ __forceinline__ void operator()(const f32x4 (&acc)[2][2][4][2], const Unit& u, int wr, int wc, int fr, int fq) const {
        const int row0 = u.pm * BM + wr * 64 + fr, col0 = u.pn * BM + wc * 32 + 8 * fq;
#pragma unroll
        for (int ai = 0; ai < 2; ++ai)
#pragma unroll
            for (int m = 0; m < 4; ++m) { bf16_t* rowp = O + (size_t)(row0 + ai * HALF + m * 16) * ldc + col0;
#pragma unroll
                for (int bj = 0; bj < 2; ++bj) { f32x4 v0 = acc[ai][bj][m][0], v1 = acc[ai][bj][m][1];
                    v0 = __builtin_elementwise_max(v0, (f32x4){0.f, 0.f, 0.f, 0.f}); v1 = __builtin_elementwise_max(v1, (f32x4){0.f, 0.f, 0.f, 0.f}); v0 = v0 * v0; v1 = v1 * v1;
                    u32x4 w; w.x = cvt_pk_bf16(v0[0], v0[1]); w.y = cvt_pk_bf16(v0[2], v0[3]); w.z = cvt_pk_bf16(v1[0], v1[1]); w.w = cvt_pk_bf16(v1[2], v1[3]);
                    *(u32x4*)(rowp + bj * HALF) = w; } }
    }
};

template <class Epi, class Sched, bool ALIGN_EPI = false, bool SP2 = false>
__device__ __forceinline__ void gemm_phase(PG8_LAS unsigned char* lds, const Gemm g, const Sched& S, const Epi& E) {
    const int tid = threadIdx.x, wid = __builtin_amdgcn_readfirstlane(tid >> 6), lane = tid & 63, wr = wid >> 2, wc = wid & 3, fr = lane & 15, fq = lane >> 4;
    const int K = g.K, nt = K / BK;
    unsigned voffA[2], voffB[2];
#pragma unroll
    for (int i = 0; i < 2; ++i) { int R, C; stage_rc(tid * 16 + i * 8192, R, C); const int Rb = Epi::PERM ? ((R & ~31) + perm32(R & 31)) : R;
        voffA[i] = (unsigned)(R * K + C) * 2u; voffB[i] = (unsigned)(Rb * K + C) * 2u; }
    const size_t kstep = (size_t)(BK * 2);
    const size_t hstep = (size_t)HALF * K * 2;
    const size_t tstep = 2 * hstep;
    const unsigned ldsw = (unsigned)wid * 1024u;
    const int aoff = lds_byte(wr * 64 + fr, fq * 8), boff = lds_byte(wc * 32 + fr, fq * 8);
#define PG8_SA(b, h) (((b) * 2 + (h)) * HTB)
#define PG8_SB(b, h) ((4 + (b) * 2 + (h)) * HTB)
#define PG8_STAGE(bufoff, gbase, voff) do { _Pragma("unroll") for (int _i = 0; _i < 2; ++_i) \
        __builtin_amdgcn_global_load_lds((const unsigned*)((const char*)(gbase) + (voff)[_i]), (PG8_LAS unsigned*)(lds + (bufoff) + ldsw + _i * 8192), 16, 0, 0); } while (0)
#define PG8_LDA(dst, b, h) do { _Pragma("unroll") for (int m = 0; m < 4; ++m) _Pragma("unroll") for (int k = 0; k < 2; ++k) dst[m][k] = *(const PG8_LAS bf16x8*)(lds + PG8_SA(b, h) + aoff + m * 2048 + k * 1024); } while (0)
#define PG8_LDB(dst, b, h) do { _Pragma("unroll") for (int n = 0; n < 2; ++n) _Pragma("unroll") for (int k = 0; k < 2; ++k) dst[n][k] = *(const PG8_LAS bf16x8*)(lds + PG8_SB(b, h) + boff + n * 2048 + k * 1024); } while (0)
#define PG8_MMA(ai, bj, At, Bt) do { __builtin_amdgcn_s_setprio(1); _Pragma("unroll") for (int m = 0; m < 4; ++m) _Pragma("unroll") for (int n = 0; n < 2; ++n) _Pragma("unroll") for (int k = 0; k < 2; ++k) \
        acc[ai][bj][m][n] = __builtin_amdgcn_mfma_f32_16x16x32_bf16(Bt[n][k], At[m][k], acc[ai][bj][m][n], 0, 0, 0); __builtin_amdgcn_s_setprio(0); } while (0)
#define PG8_WAIT_V(n) asm volatile("s_waitcnt vmcnt(" #n ")" ::: "memory")
#define PG8_WAIT_L(n) asm volatile("s_waitcnt lgkmcnt(" #n ")" ::: "memory")
#define PG8_BAR __builtin_amdgcn_s_barrier()
#define PG8_SCHED __builtin_amdgcn_sched_barrier(0)
    Unit cur, nxt; int ui = 0;
    if (!S.next(0, cur)) return;
    f32x4 acc[2][2][4][2];
#pragma unroll
    for (int a = 0; a < 2; ++a)
#pragma unroll
        for (int b = 0; b < 2; ++b)
#pragma unroll
            for (int m = 0; m < 4; ++m)
#pragma unroll
                for (int n = 0; n < 2; ++n) acc[a][b][m][n] = (f32x4){0.f, 0.f, 0.f, 0.f};
    bf16x8 At[4][2], B0[2][2], B1[2][2];
    const char* cA = (const char*)g.A + (size_t)cur.pm * tstep; const char* cB = (const char*)g.Bt + (size_t)cur.pn * tstep;
    S.a_ready(cur);
    if constexpr (SP2) {
        PG8_STAGE(PG8_SB(0, 0), cB, voffB); PG8_STAGE(PG8_SB(0, 1), cB + hstep, voffB); PG8_STAGE(PG8_SA(0, 0), cA, voffA); PG8_STAGE(PG8_SA(0, 1), cA + hstep, voffA);
        if (wr == 1) PG8_BAR;
        PG8_WAIT_V(2); PG8_BAR;
        PG8_STAGE(PG8_SB(1, 0), cB + kstep, voffB); PG8_STAGE(PG8_SA(1, 0), cA + kstep, voffA); PG8_STAGE(PG8_SB(1, 1), cB + hstep + kstep, voffB);
        PG8_WAIT_V(6); PG8_BAR;
    } else {
        PG8_STAGE(PG8_SB(0, 0), cB, voffB); PG8_STAGE(PG8_SA(0, 0), cA, voffA); PG8_STAGE(PG8_SB(0, 1), cB + hstep, voffB); PG8_STAGE(PG8_SA(0, 1), cA + hstep, voffA);
        if (wr == 1) PG8_BAR;
        PG8_WAIT_V(4); PG8_BAR;
        PG8_STAGE(PG8_SB(1, 0), cB + kstep, voffB); PG8_STAGE(PG8_SA(1, 0), cA + kstep, voffA); PG8_STAGE(PG8_SB(1, 1), cB + hstep + kstep, voffB);
        PG8_WAIT_V(6); PG8_BAR;
    }
    for (;;) {
        const bool has_next = S.next(ui + 1, nxt);
        const char* nA = has_next ? (const char*)g.A + (size_t)nxt.pm * tstep : cA; const char* nB = has_next ? (const char*)g.Bt + (size_t)nxt.pn * tstep : cB;
        for (int t = 0; t < nt; t += 2) {
            const bool last = (t == nt - 2);
            const char* a1 = cA + (size_t)(t + 1) * kstep;
            const char* a2 = last ? nA : cA + (size_t)(t + 2) * kstep; const char* b2 = last ? nB : cB + (size_t)(t + 2) * kstep;
            const char* a3 = a2 + kstep; const char* b3 = b2 + kstep;
            if (last && has_next) S.a_ready(nxt);
            if constexpr (SP2) {
            PG8_LDB(B0, 0, 0); PG8_LDB(B1, 0, 1); PG8_SCHED; PG8_LDA(At, 0, 0); PG8_STAGE(PG8_SA(1, 1), a1 + hstep, voffA);
            PG8_WAIT_V(8); PG8_WAIT_L(0); PG8_BAR; PG8_MMA(0, 0, At, B0); PG8_MMA(0, 1, At, B1); PG8_BAR; PG8_SCHED;
            PG8_LDA(At, 0, 1); PG8_STAGE(PG8_SB(0, 0), b2, voffB); PG8_STAGE(PG8_SB(0, 1), b2 + hstep, voffB); PG8_STAGE(PG8_SA(0, 0), a2, voffA);
            PG8_WAIT_V(8); PG8_WAIT_L(0); PG8_BAR; PG8_MMA(1, 0, At, B0); PG8_MMA(1, 1, At, B1); PG8_BAR; PG8_SCHED;
            PG8_LDB(B0, 1, 0); PG8_LDB(B1, 1, 1); PG8_SCHED; PG8_LDA(At, 1, 0); PG8_STAGE(PG8_SA(0, 1), a2 + hstep, voffA);
            PG8_WAIT_V(8); PG8_WAIT_L(0); PG8_BAR; PG8_MMA(0, 0, At, B0); PG8_MMA(0, 1, At, B1); PG8_BAR; PG8_SCHED;
            PG8_LDA(At, 1, 1); PG8_STAGE(PG8_SB(1, 0), b3, voffB); PG8_STAGE(PG8_SB(1, 1), b3 + hstep, voffB); PG8_STAGE(PG8_SA(1, 0), a3, voffA);
            PG8_WAIT_V(8); PG8_WAIT_L(0); PG8_BAR; PG8_MMA(1, 0, At, B0); PG8_MMA(1, 1, At, B1); PG8_BAR; PG8_SCHED;
            } else {
            PG8_LDB(B0, 0, 0); PG8_SCHED; PG8_LDA(At, 0, 0); PG8_STAGE(PG8_SA(1, 1), a1 + hstep, voffA);
            PG8_WAIT_L(8); PG8_BAR; PG8_WAIT_L(0); PG8_MMA(0, 0, At, B0); PG8_BAR; PG8_SCHED;
            PG8_LDB(B1, 0, 1); PG8_STAGE(PG8_SB(0, 0), b2, voffB);
            PG8_BAR; PG8_WAIT_L(0); PG8_MMA(0, 1, At, B1); PG8_BAR;
            PG8_LDA(At, 0, 1); PG8_STAGE(PG8_SA(0, 0), a2, voffA);
            PG8_BAR; PG8_WAIT_L(0); PG8_MMA(1, 0, At, B0); PG8_BAR; PG8_SCHED;
            PG8_STAGE(PG8_SB(0, 1), b2 + hstep, voffB);
            PG8_WAIT_V(6); PG8_BAR; PG8_MMA(1, 1, At, B1); PG8_BAR;
            PG8_LDB(B0, 1, 0); PG8_SCHED; PG8_LDA(At, 1, 0); PG8_STAGE(PG8_SA(0, 1), a2 + hstep, voffA);
            PG8_WAIT_L(8); PG8_BAR; PG8_WAIT_L(0); PG8_MMA(0, 0, At, B0); PG8_BAR; PG8_SCHED;
            PG8_LDB(B1, 1, 1); PG8_STAGE(PG8_SB(1, 0), b3, voffB);
            PG8_BAR; PG8_WAIT_L(0); PG8_MMA(0, 1, At, B1); PG8_BAR;
            PG8_LDA(At, 1, 1); PG8_STAGE(PG8_SA(1, 0), a3, voffA);
            PG8_BAR; PG8_WAIT_L(0); PG8_MMA(1, 0, At, B0); PG8_BAR; PG8_SCHED;
            PG8_STAGE(PG8_SB(1, 1), b3 + hstep, voffB);
            PG8_WAIT_V(6); PG8_BAR; PG8_MMA(1, 1, At, B1); PG8_BAR;
            }
        }
        if constexpr (ALIGN_EPI) { if (wr == 0) PG8_BAR; }
        if constexpr (!Epi::AFTER_DRAIN) { E(acc, cur, wr, wc, fr, fq); S.done(cur); }
        if (!has_next) break;
#pragma unroll
        for (int a = 0; a < 2; ++a)
#pragma unroll
            for (int b = 0; b < 2; ++b)
#pragma unroll
                for (int m = 0; m < 4; ++m)
#pragma unroll
                    for (int n = 0; n < 2; ++n) acc[a][b][m][n] = (f32x4){0.f, 0.f, 0.f, 0.f};
        cur = nxt; cA = nA; cB = nB; ++ui;
        if constexpr (ALIGN_EPI) { if (wr == 1) PG8_BAR; }
    }
    PG8_WAIT_V(0);
    if constexpr (!ALIGN_EPI) { if (wr == 0) PG8_BAR; }
    PG8_BAR;
    if constexpr (Epi::AFTER_DRAIN) { E.fused(acc, cur, wr, wc, fr, fq, lds, wid, lane); S.done(cur); }
#undef PG8_SA
#undef PG8_SB
#undef PG8_STAGE
#undef PG8_LDA
#undef PG8_LDB
#undef PG8_MMA
#undef PG8_WAIT_V
#undef PG8_WAIT_L
#undef PG8_BAR
#undef PG8_SCHED
}
}

constexpr int DM = 2048, SEQ = 8192, CTX = 256, MROWS = SEQ + CTX, INW = 2560, DFF = 8192, NMOD = 6 * DM;
constexpr float EPS = 1e-6f;
constexpr int NWAVES = 8, NTHR = 512;
constexpr size_t MiB = 1u << 20;
constexpr size_t WS_CTL = 0, CTL_ZERO_BYTES = 128 * 1024;
constexpr size_t OFF_MOD = 0, OFF_CMOD = 64 * 1024;
constexpr size_t OFF_BAR = 96 * 1024;
constexpr size_t OFF_ROPE = 512 * 1024;
constexpr size_t WS_WIN = 1 * MiB, WS_WOUT = 11 * MiB, WS_WUP = 19 * MiB, WS_WDN = 51 * MiB;
constexpr size_t WS_H = 83 * MiB;
constexpr size_t WS_X1 = 116 * MiB;
constexpr size_t WS_ACT = 180 * MiB;
constexpr size_t WS_P = 180 * MiB;
constexpr size_t WS_MIX = 222 * MiB;
constexpr size_t WS_END = 308 * MiB;
static_assert(WS_P + (size_t)MROWS * INW * 2 <= WS_MIX && WS_MIX + (size_t)SEQ * DM * 2 <= WS_END && WS_H + (size_t)MROWS * DM * 2 <= WS_X1, "d_ws map");

#define LAS __attribute__((address_space(3)))
typedef unsigned short bf16;
typedef unsigned v4u __attribute__((ext_vector_type(4)));
typedef unsigned v2u __attribute__((ext_vector_type(2)));
typedef float f32x4 __attribute__((ext_vector_type(4)));
typedef float f32x16 __attribute__((ext_vector_type(16)));
typedef short bf16x8 __attribute__((ext_vector_type(8)));
typedef short s16x4 __attribute__((ext_vector_type(4)));
#define LDS_WAIT() asm volatile("s_waitcnt lgkmcnt(0)" ::: "memory")
__device__ __forceinline__ unsigned pk2(float lo, float hi) { return pg8::cvt_pk_bf16(lo, hi); }
__device__ __forceinline__ float bf2f(unsigned short b) { return __uint_as_float((unsigned)b << 16); }
__device__ __forceinline__ float wave_sum(float v) {
#pragma unroll
    for (int o = 1; o < 64; o <<= 1) v += __shfl_xor(v, o);
    return v;
}
__device__ __forceinline__ float rl(float v, int l) { return __uint_as_float(__builtin_amdgcn_readlane(__float_as_uint(v), l)); }

#define XB_TMO      128
#define XB_XCNT(j)  (256  + 64 * (j))
#define XB_XSUB(j)  (1280 + 64 * (j))
#define XB_XGEN(j)  (2304 + 64 * (j))
#define XB_TOP      3328
#define XB_TOPGEN   3392
#define XCD_BAR_WORDS 3456
#define XB_SPIN_CAP (1u << 18)

__device__ __forceinline__ unsigned xb_ld(unsigned* p)              { return __hip_atomic_load(p, __ATOMIC_RELAXED, __HIP_MEMORY_SCOPE_AGENT); }
__device__ __forceinline__ unsigned xb_add(unsigned* p, unsigned v) { return __hip_atomic_fetch_add(p, v, __ATOMIC_RELAXED, __HIP_MEMORY_SCOPE_AGENT); }
__device__ __forceinline__ unsigned xb_xcc_id() { return (unsigned)__builtin_amdgcn_s_getreg((3 << 11) | 20) & 0xFu; }
#define XB_SPIN(cond, bar) do { unsigned _sp = 0; while (cond) { __builtin_amdgcn_s_sleep(1); \
    if ((++_sp & 255u) == 0u) { if (xb_ld(&(bar)[XB_TMO])) break; if (_sp > XB_SPIN_CAP) { atomicAdd(&(bar)[XB_TMO], 1u); break; } } } } while (0)

struct XcdBarrier {
    unsigned* bar; unsigned x;
    volatile LAS unsigned* st;
};

__device__ __forceinline__ XcdBarrier xcd_barrier_post(unsigned* bar, volatile LAS unsigned* st) {
    XcdBarrier b; b.bar = bar; b.x = xb_xcc_id(); b.st = st;
    if (threadIdx.x == 0) (void)xb_add(&bar[XB_XCNT(b.x)], 1u);
    return b;
}
__device__ __forceinline__ void xcd_barrier_complete(unsigned* bar, unsigned x, unsigned& nloc, unsigned& nx) {
    const unsigned G = gridDim.x * gridDim.y * gridDim.z;
    unsigned sum, cnt, mine, sp = 0u;
    for (;;) {
        sum = 0u; cnt = 0u; mine = 0u;
#pragma unroll
        for (unsigned j = 0; j < 16; ++j) { const unsigned c = xb_ld(&bar[XB_XCNT(j)]); sum += c; cnt += (c > 0u) ? 1u : 0u; mine = (j == x) ? c : mine; }
        if (sum == G) break;
        __builtin_amdgcn_s_sleep(1);
        if ((++sp & 255u) == 0u) { if (xb_ld(&bar[XB_TMO])) break; if (sp > XB_SPIN_CAP) { atomicAdd(&bar[XB_TMO], 1u); break; } }
    }
    nloc = mine > 0u ? mine : 1u; nx = cnt > 0u ? cnt : 1u;
}

__device__ __forceinline__ void xcd_barrier(const XcdBarrier& b) {
    asm volatile("s_waitcnt vmcnt(0)" ::: "memory");
    __syncthreads();
    if (threadIdx.x == 0) {
        unsigned* bar = b.bar;
        __builtin_amdgcn_s_waitcnt(0);
        unsigned nloc = b.st[0], nx = b.st[1];
        if (nloc == 0u) { xcd_barrier_complete(bar, b.x, nloc, nx); b.st[0] = nloc; b.st[1] = nx; }
        const unsigned old = xb_add(&bar[XB_XSUB(b.x)], 1u);
        const unsigned gen = old / nloc;
        if (old + 1u == (gen + 1u) * nloc) {
            __builtin_amdgcn_fence(__ATOMIC_RELEASE, "agent");
            asm volatile("s_waitcnt vmcnt(0)" ::: "memory");
            const unsigned og = xb_add(&bar[XB_TOP], 1u);
            const unsigned tg = og / nx;
            if (og + 1u == (tg + 1u) * nx) xb_add(&bar[XB_TOPGEN], 1u);
            else XB_SPIN(xb_ld(&bar[XB_TOPGEN]) == tg, bar);
            __builtin_amdgcn_fence(__ATOMIC_ACQUIRE, "agent");
            xb_add(&bar[XB_XGEN(b.x)], 1u);
            asm volatile("s_waitcnt vmcnt(0)" ::: "memory");
        } else {
            XB_SPIN(xb_ld(&bar[XB_XGEN(b.x)]) == gen, bar);
            __builtin_amdgcn_fence(__ATOMIC_ACQUIRE, "agent");
            asm volatile("s_waitcnt vmcnt(0)" ::: "memory");
        }
    }
    __syncthreads();
}

__device__ __forceinline__ void transpose_item(const float* W, int ldw, int ncol0, int nblk, int K, bf16* WT, LAS float* scr, int item, int lane) {
    const int kb = item / nblk, nb = item % nblk, k0 = 64 * kb, n0 = 32 * nb;
#pragma unroll 8
    for (int i = 0; i < 32; ++i) { const int kk = 2 * i + (lane >> 5); scr[kk * 33 + (lane & 31)] = W[(size_t)(k0 + kk) * ldw + ncol0 + n0 + (lane & 31)]; }
    LDS_WAIT(); asm volatile("" ::: "memory");
    const int c = lane & 7;
#pragma unroll
    for (int j = 0; j < 4; ++j) { const int n = (lane >> 3) + 8 * j; const LAS float* s = scr + (8 * c) * 33 + n;
        v4u o; o.x = pk2(s[0 * 33], s[1 * 33]); o.y = pk2(s[2 * 33], s[3 * 33]); o.z = pk2(s[4 * 33], s[5 * 33]); o.w = pk2(s[6 * 33], s[7 * 33]);
        *(v4u*)(WT + (size_t)(n0 + n) * K + k0 + 8 * c) = o; }
    LDS_WAIT(); asm volatile("" ::: "memory");
}
__device__ __forceinline__ void fold_item(const float* w_in, const float* pool_w, const float* pool_scale, bf16* Win_t, int item, int lane) {
    const int g = item >> 10, kb = (item >> 2) & 255, dq = item & 3, k0 = kb * 8, d = dq * 64 + lane;
    float wreg[8][4];
#pragma unroll
    for (int kk = 0; kk < 8; ++kk)
#pragma unroll
        for (int j = 0; j < 4; ++j) wreg[kk][j] = w_in[(size_t)(k0 + kk) * INW + 1536 + g * 256 + j * 64 + lane];
    float acc[8];
#pragma unroll
    for (int kk = 0; kk < 8; ++kk) acc[kk] = 0.f;
    const float* pw = pool_w + (size_t)g * 65536 + d;
#pragma unroll
    for (int j = 0; j < 4; ++j) {
#pragma unroll 4
        for (int cc = 0; cc < 64; ++cc) { const float p = pw[(size_t)(j * 64 + cc) * 256];
#pragma unroll
            for (int kk = 0; kk < 8; ++kk) acc[kk] = fmaf(rl(wreg[kk][j], cc), p, acc[kk]); }
    }
    const float sc = pool_scale[g * 256 + d];
    v4u o; o.x = pk2(acc[0] * sc, acc[1] * sc); o.y = pk2(acc[2] * sc, acc[3] * sc); o.z = pk2(acc[4] * sc, acc[5] * sc); o.w = pk2(acc[6] * sc, acc[7] * sc);
    *(v4u*)(Win_t + (size_t)(1536 + g * 256 + d) * DM + k0) = o;
}
__device__ __forceinline__ float silu(float v) { return v / (1.f + __expf(-v)); }
__device__ __forceinline__ void ada_item(const float* c, const float* cctx, const float* w_ada, const float* b_ada, float* mod, float* cmod, int item, int lane) {
    const int kc = item / 48, nb = item % 48, k0 = kc * 64, n0 = nb * 256 + 4 * lane;
    const float s = silu(c[k0 + lane]), sx = silu(cctx[k0 + lane]);
    f32x4 a = (f32x4){0.f, 0.f, 0.f, 0.f}, ax = a;
    const bool dox = nb < 16;
    const float* wp = w_ada + (size_t)k0 * NMOD + n0;
#pragma unroll 8
    for (int kk = 0; kk < 64; ++kk) { const f32x4 w = *(const f32x4*)(wp + (size_t)kk * NMOD); a += w * rl(s, kk); ax += w * rl(sx, kk); }
    if (kc == 0) { const f32x4 b = *(const f32x4*)(b_ada + n0); a += b; ax += b; }
#pragma unroll
    for (int j = 0; j < 4; ++j) __hip_atomic_fetch_add(mod + n0 + j, a[j], __ATOMIC_RELAXED, __HIP_MEMORY_SCOPE_AGENT);
    if (dox) {
#pragma unroll
        for (int j = 0; j < 4; ++j) __hip_atomic_fetch_add(cmod + n0 + j, ax[j], __ATOMIC_RELAXED, __HIP_MEMORY_SCOPE_AGENT);
    }
}
__device__ __forceinline__ void rope_entry(float* rope, int idx) {
    const int pos = idx >> 4, i = idx & 15;
    const float inv = (float)exp2(-(double)i * (13.287712379549449 / 16.0));
    const float angf = (float)pos * inv;
    const double TWO_PI = 6.283185307179586476925;
    double r = (double)angf; r -= TWO_PI * rint(r / TWO_PI);
    const double r2 = r * r; double sterm = r, cterm = 1.0, sn = r, cs = 1.0;
    for (int n = 1; n <= 15; ++n) { cterm *= -r2 / (double)((2 * n - 1) * (2 * n)); sterm *= -r2 / (double)((2 * n) * (2 * n + 1)); cs += cterm; sn += sterm; }
    rope[idx] = (float)cs; rope[2048 + idx] = (float)sn;
}
__device__ __forceinline__ void norm_mod_row(const float* xrow, bf16* orow, const f32x4 (&ab)[8], const f32x4 (&sb)[8], int lane) {
    const f32x4* xr = (const f32x4*)xrow + lane;
    f32x4 v[8]; float ss = 0.f;
#pragma unroll
    for (int j = 0; j < 8; ++j) { v[j] = xr[64 * j]; ss += (v[j].x * v[j].x + v[j].y * v[j].y) + (v[j].z * v[j].z + v[j].w * v[j].w); }
    const float rstd = 1.0f / sqrtf(wave_sum(ss) * (1.f / DM) + EPS);
    v2u* o8 = (v2u*)orow + lane;
#pragma unroll
    for (int j = 0; j < 8; ++j) { const f32x4 y = v[j] * rstd * ab[j] + sb[j]; v2u w; w.x = pk2(y.x, y.y); w.y = pk2(y.z, y.w); o8[64 * j] = w; }
}
__device__ __forceinline__ void norm_mod_pass(const float* X, int row_lo, int row_hi, bf16* Hrows, const float* nw, const float* shift, const float* scale, int gw, int NGW, int lane) {
    f32x4 ab[8], sb[8];
#pragma unroll
    for (int j = 0; j < 8; ++j) { const int cidx = 4 * lane + 256 * j; const f32x4 w = *(const f32x4*)(nw + cidx), sc = *(const f32x4*)(scale + cidx); ab[j] = w * (sc + 1.0f); sb[j] = *(const f32x4*)(shift + cidx); }
    for (int m = row_lo + gw; m < row_hi; m += NGW) norm_mod_row(X + (size_t)(m - row_lo) * DM, Hrows + (size_t)m * DM, ab, sb, lane);
}

namespace att {
constexpr int KS = 144, VS = 192;
constexpr int KBUF = 64 * KS, VBUF = 64 * VS;
constexpr int OFF_K = 0, OFF_V = 2 * KBUF;
constexpr float LOG2E = 1.4426950408889634f;
typedef short v4i16_t __attribute__((ext_vector_type(4)));
__device__ __forceinline__ s16x4 vtr(LAS unsigned char* p) { return __builtin_bit_cast(s16x4, __builtin_amdgcn_ds_read_tr16_b64_v4i16((LAS v4i16_t*)p)); }
__device__ __forceinline__ int tile_row0(int t, int b) { return t < 4 ? SEQ + 64 * t : 128 * b - 128 + 64 * (t - 4); }
__device__ __forceinline__ void attn_unit(LAS unsigned char* lds, const bf16* P, bf16* MIX, const float* sink, int b, int h) {
    const int tid = threadIdx.x, lane = tid & 63, r32 = lane & 31, hi = lane >> 5, wid = __builtin_amdgcn_readfirstlane(tid >> 6);
    const int head = 4 * h + (wid & 3), q0 = 128 * b + 64 * (wid >> 2);
    bf16x8 qf[2][4];
#pragma unroll
    for (int qb = 0; qb < 2; ++qb)
#pragma unroll
        for (int d0 = 0; d0 < 4; ++d0) qf[qb][d0] = *(const bf16x8*)(P + (size_t)(q0 + 32 * qb + r32) * INW + head * 64 + d0 * 16 + hi * 8);
    float mrun[2], lrun[2]; f32x16 o[2][2];
    const float sk = sink[head] * LOG2E;
#pragma unroll
    for (int qb = 0; qb < 2; ++qb) { mrun[qb] = sk; lrun[qb] = hi == 0 ? 1.f : 0.f;
#pragma unroll
        for (int db = 0; db < 2; ++db)
#pragma unroll
            for (int r = 0; r < 16; ++r) o[db][qb][r] = 0.f; }
    const int srow = tid >> 3, sch = tid & 7;
    const bf16* kbase = P + 1024 + h * 64 + sch * 8; const bf16* vbase = P + 1280 + h * 64 + sch * 8;
    const int tend = (b == 63) ? 8 : 10;
    v4u kreg, vreg;
    { const size_t ro = (size_t)(tile_row0(0, b) + srow) * INW; kreg = *(const v4u*)(kbase + ro); vreg = *(const v4u*)(vbase + ro); }
    *(LAS v4u*)(lds + OFF_K + srow * KS + sch * 16) = kreg; *(LAS v4u*)(lds + OFF_V + srow * VS + sch * 16) = vreg;
    __syncthreads();
    const int kread = r32 * KS + hi * 16;
    const int vread = (((lane & 15) >> 2) + 4 * hi) * VS + (16 * ((lane >> 4) & 1) + 4 * (lane & 3)) * 2;
    int t = 0, buf = 0;
    for (;;) {
        int tn = t + 1; if (b == 0 && tn == 4) tn = 6;
        const bool has = tn < tend;
        if (has) { const size_t ro = (size_t)(tile_row0(tn, b) + srow) * INW; kreg = *(const v4u*)(kbase + ro); vreg = *(const v4u*)(vbase + ro); }
        int dt = 0; bool act = true;
        if (t >= 4) { const int k0 = 128 * b - 128 + 64 * (t - 4); dt = (k0 - q0) / 64; act = (dt >= -2 && dt <= 2); }
        if (act) {
            LAS unsigned char* Kb = lds + OFF_K + buf * KBUF; LAS unsigned char* Vb = lds + OFF_V + buf * VBUF;
            f32x16 p[2][2];
#pragma unroll
            for (int kb = 0; kb < 2; ++kb)
#pragma unroll
                for (int qb = 0; qb < 2; ++qb)
#pragma unroll
                    for (int r = 0; r < 16; ++r) p[kb][qb][r] = 0.f;
#pragma unroll
            for (int kb = 0; kb < 2; ++kb)
#pragma unroll
                for (int d0 = 0; d0 < 4; ++d0) { const bf16x8 kf = *(const LAS bf16x8*)(Kb + kread + kb * 32 * KS + d0 * 32);
#pragma unroll
                    for (int qb = 0; qb < 2; ++qb) p[kb][qb] = __builtin_amdgcn_mfma_f32_32x32x16_bf16(kf, qf[qb][d0], p[kb][qb], 0, 0, 0); }
            if (dt == 2 || dt == -2) {
#pragma unroll
                for (int kb = 0; kb < 2; ++kb)
#pragma unroll
                    for (int qb = 0; qb < 2; ++qb)
#pragma unroll
                        for (int r = 0; r < 16; ++r) { const int dkq = 64 * dt + 32 * kb + (r & 3) + 8 * (r >> 2) + 4 * hi - (32 * qb + r32);
                            if (dkq > 128 || dkq < -128) p[kb][qb][r] = -1e30f; }
            }
#pragma unroll
            for (int qb = 0; qb < 2; ++qb) {
                float mx = p[0][qb][0];
#pragma unroll
                for (int kb = 0; kb < 2; ++kb)
#pragma unroll
                    for (int r = 0; r < 16; ++r) mx = fmaxf(mx, p[kb][qb][r]);
                mx = fmaxf(mx, __shfl_xor(mx, 32));
                const float mn = fmaxf(mrun[qb], mx), alpha = __builtin_amdgcn_exp2f(mrun[qb] - mn); mrun[qb] = mn;
                float s = 0.f;
#pragma unroll
                for (int kb = 0; kb < 2; ++kb)
#pragma unroll
                    for (int r = 0; r < 16; ++r) { const float e = __builtin_amdgcn_exp2f(p[kb][qb][r] - mn); p[kb][qb][r] = e; s += e; }
                lrun[qb] = lrun[qb] * alpha + s;
#pragma unroll
                for (int db = 0; db < 2; ++db)
#pragma unroll
                    for (int r = 0; r < 16; ++r) o[db][qb][r] *= alpha;
            }
#pragma unroll
            for (int kb = 0; kb < 2; ++kb)
#pragma unroll
                for (int s2 = 0; s2 < 2; ++s2) {
                    bf16x8 pb[2];
#pragma unroll
                    for (int qb = 0; qb < 2; ++qb) { v4u w; w.x = pk2(p[kb][qb][8 * s2 + 0], p[kb][qb][8 * s2 + 1]); w.y = pk2(p[kb][qb][8 * s2 + 2], p[kb][qb][8 * s2 + 3]);
                        w.z = pk2(p[kb][qb][8 * s2 + 4], p[kb][qb][8 * s2 + 5]); w.w = pk2(p[kb][qb][8 * s2 + 6], p[kb][qb][8 * s2 + 7]); pb[qb] = __builtin_bit_cast(bf16x8, w); }
#pragma unroll
                    for (int db = 0; db < 2; ++db) {
                        LAS unsigned char* vp = Vb + vread + (32 * kb + 16 * s2) * VS + 64 * db;
                        const s16x4 lo = vtr(vp), hi4 = vtr(vp + 8 * VS);
                        const bf16x8 vf = (bf16x8){lo[0], lo[1], lo[2], lo[3], hi4[0], hi4[1], hi4[2], hi4[3]};
#pragma unroll
                        for (int qb = 0; qb < 2; ++qb) o[db][qb] = __builtin_amdgcn_mfma_f32_32x32x16_bf16(vf, pb[qb], o[db][qb], 0, 0, 0);
                    }
                }
        }
        if (has) { *(LAS v4u*)(lds + OFF_K + (buf ^ 1) * KBUF + srow * KS + sch * 16) = kreg; *(LAS v4u*)(lds + OFF_V + (buf ^ 1) * VBUF + srow * VS + sch * 16) = vreg; }
        __syncthreads();
        if (!has) break;
        t = tn; buf ^= 1;
    }
#pragma unroll
    for (int qb = 0; qb < 2; ++qb) {
        const float lt = lrun[qb] + __shfl_xor(lrun[qb], 32), inv = 1.0f / lt;
        bf16* orow = MIX + (size_t)(q0 + 32 * qb + r32) * DM + head * 64 + 4 * hi;
#pragma unroll
        for (int db = 0; db < 2; ++db)
#pragma unroll
            for (int a = 0; a < 4; ++a) { v2u w; w.x = pk2(o[db][qb][4 * a] * inv, o[db][qb][4 * a + 1] * inv); w.y = pk2(o[db][qb][4 * a + 2] * inv, o[db][qb][4 * a + 3] * inv);
                *(v2u*)(orow + 32 * db + 8 * a) = w; }
    }
}
}

__device__ __forceinline__ void pool_item(const bf16* P, bf16* MIX, int idx) {
    const int t = idx >> 7, ch = idx & 127, g = ch >> 5, w = 2 << g;
    int lo = t - (w >> 1), hi = lo + w; lo = lo < 0 ? 0 : lo; hi = hi > SEQ ? SEQ : hi;
    const bf16* up = P + 1536 + ch * 8;
    float s[8];
#pragma unroll
    for (int e = 0; e < 8; ++e) s[e] = 0.f;
    for (int tt = lo; tt < hi; ++tt) { const v4u v = *(const v4u*)(up + (size_t)tt * INW);
        s[0] += __uint_as_float(v.x << 16); s[1] += __uint_as_float(v.x & 0xffff0000u); s[2] += __uint_as_float(v.y << 16); s[3] += __uint_as_float(v.y & 0xffff0000u);
        s[4] += __uint_as_float(v.z << 16); s[5] += __uint_as_float(v.z & 0xffff0000u); s[6] += __uint_as_float(v.w << 16); s[7] += __uint_as_float(v.w & 0xffff0000u); }
    const v4u c = *(const v4u*)(up + (size_t)t * INW);
    const float inv = 1.0f / (float)(hi - lo);
    float ce[8] = {__uint_as_float(c.x << 16), __uint_as_float(c.x & 0xffff0000u), __uint_as_float(c.y << 16), __uint_as_float(c.y & 0xffff0000u),
                   __uint_as_float(c.z << 16), __uint_as_float(c.z & 0xffff0000u), __uint_as_float(c.w << 16), __uint_as_float(c.w & 0xffff0000u)};
    v4u o; o.x = pk2(s[0] * inv - ce[0], s[1] * inv - ce[1]); o.y = pk2(s[2] * inv - ce[2], s[3] * inv - ce[3]); o.z = pk2(s[4] * inv - ce[4], s[5] * inv - ce[5]); o.w = pk2(s[6] * inv - ce[6], s[7] * inv - ce[7]);
    *(v4u*)(MIX + (size_t)t * DM + 1024 + ch * 8) = o;
}

constexpr int LDS_BYTES = 147456;
constexpr int NPHASE = 9;
struct Args { const float* in[16]; float* out; unsigned char* ws; int ph_lo, ph_hi; };
__global__ void __launch_bounds__(NTHR, 2) fwd_megakernel(Args args) {
    extern __shared__ __attribute__((aligned(16))) unsigned char lds_raw[];
    cg::grid_group grid = cg::this_grid();
    LAS unsigned char* lds = (LAS unsigned char*)lds_raw;
    const int tid = threadIdx.x, lane = tid & 63, wave = __builtin_amdgcn_readfirstlane(tid >> 6);
    const int G = gridDim.x, bx = blockIdx.x;
    const int gw = bx * NWAVES + wave, NGW = G * NWAVES;
    const float *x = args.in[0], *cvec = args.in[1], *ctx = args.in[2], *cctx = args.in[3], *norm_attn_w = args.in[4], *norm_mlp_w = args.in[5], *w_ada = args.in[6], *b_ada = args.in[7],
                *w_in = args.in[8], *attn_sink = args.in[9], *pool_w = args.in[10], *pool_scale = args.in[11], *w_out = args.in[12], *w_up = args.in[13], *w_dn = args.in[14], *final_w = args.in[15];
    unsigned char* ws = args.ws;
    float* mod = (float*)(ws + OFF_MOD); float* cmod = (float*)(ws + OFF_CMOD); float* rope = (float*)(ws + OFF_ROPE);
    bf16 *Win_t = (bf16*)(ws + WS_WIN), *Wout_t = (bf16*)(ws + WS_WOUT), *Wup_t = (bf16*)(ws + WS_WUP), *Wdn_t = (bf16*)(ws + WS_WDN);
    bf16 *H = (bf16*)(ws + WS_H), *P = (bf16*)(ws + WS_P), *MIX = (bf16*)(ws + WS_MIX), *ACT = (bf16*)(ws + WS_ACT);
    float* X1 = (float*)(ws + WS_X1);
    const int lo = args.ph_lo, hi = args.ph_hi;
    volatile LAS unsigned* MISC = (volatile LAS unsigned*)(lds + 131072);
    if (tid < 64) MISC[tid] = 0u;
    __syncthreads();
    XcdBarrier bar = xcd_barrier_post((unsigned*)(ws + OFF_BAR), MISC + 8);
    if (lo < 0) grid.sync();
#define IN(k) (lo <= (k) && (k) < hi)
#define SEAM(k) do { if (IN(k) && IN((k) + 1)) xcd_barrier(bar); } while (0)

    if (IN(0)) {
        LAS float* scr = (LAS float*)(lds + wave * 16384);
        constexpr int I_IN = 32 * 48, I_OUT = 32 * 64, I_UP = 32 * 256, I_DN = 128 * 64, I_FOLD = 4096, I_ADA = 32 * 48;
        constexpr int NITEMS = I_ADA + I_FOLD + I_IN + I_OUT + I_UP + I_DN;
        for (int it = gw; it < NITEMS; it += NGW) {
            int r = it;
            if (r < I_ADA) { ada_item(cvec, cctx, w_ada, b_ada, mod, cmod, r, lane); continue; } r -= I_ADA;
            if (r < I_FOLD) { fold_item(w_in, pool_w, pool_scale, Win_t, r, lane); continue; } r -= I_FOLD;
            if (r < I_IN) { transpose_item(w_in, INW, 0, 48, DM, Win_t, scr, r, lane); continue; } r -= I_IN;
            if (r < I_OUT) { transpose_item(w_out, DM, 0, 64, DM, Wout_t, scr, r, lane); continue; } r -= I_OUT;
            if (r < I_UP) { transpose_item(w_up, DFF, 0, 256, DM, Wup_t, scr, r, lane); continue; } r -= I_UP;
            transpose_item(w_dn, DM, 0, 64, DFF, Wdn_t, scr, r, lane);
        }
        for (int idx = bx * NTHR + tid; idx < 2048; idx += G * NTHR) rope_entry(rope, idx);
#if PROBE_P0
        for (int it = gw + I_ADA; it < NITEMS; it += NGW) {
            int r = it - I_ADA;
            if (r < I_FOLD) { fold_item(w_in, pool_w, pool_scale, Win_t, r, lane); continue; } r -= I_FOLD;
            if (r < I_IN) { transpose_item(w_in, INW, 0, 48, DM, Win_t, scr, r, lane); continue; } r -= I_IN;
            if (r < I_OUT) { transpose_item(w_out, DM, 0, 64, DM, Wout_t, scr, r, lane); continue; } r -= I_OUT;
            if (r < I_UP) { transpose_item(w_up, DFF, 0, 256, DM, Wup_t, scr, r, lane); continue; } r -= I_UP;
            transpose_item(w_dn, DM, 0, 64, DFF, Wdn_t, scr, r, lane);
        }
#endif
    }
    SEAM(0);
#if PROBE_SYNC
    for (int q = 0; q < 8; ++q) xcd_barrier(bar);
#endif
    if (IN(1)) {
        norm_mod_pass(x, 0, SEQ, H, norm_attn_w, mod, mod + DM, gw, NGW, lane);
        norm_mod_pass(ctx, SEQ, MROWS, H, norm_attn_w, cmod, cmod + DM, gw, NGW, lane);
    }
    SEAM(1);
    if (IN(2)) {
        pg8::Gemm g{H, Win_t, MROWS, INW, DM}; pg8::InProjOrder S; S.init(G, bx);
        pg8::EpiInProj E{P, rope};
        pg8::gemm_phase<pg8::EpiInProj, pg8::InProjOrder, true, true>(lds, g, S, E);
    }
    SEAM(2);
    if (IN(3)) {
        for (int u = bx; u < 256; u += G) att::attn_unit(lds, P, MIX, attn_sink, u >> 2, u & 3);
        for (int idx = bx * NTHR + tid; idx < SEQ * 128; idx += G * NTHR) pool_item(P, MIX, idx);
#if PROBE_P3
        for (int u = bx; u < 256; u += G) att::attn_unit(lds, P, MIX, attn_sink, u >> 2, u & 3);
#endif
#if PROBE_POOL
        for (int idx = bx * NTHR + tid; idx < SEQ * 128; idx += G * NTHR) pool_item(P, MIX, idx);
#endif
    }
    SEAM(3);
    if (IN(4)) {
        pg8::Gemm g{MIX, Wout_t, SEQ, DM, DM}; pg8::StaticOrder S; S.init(SEQ, DM, G, bx);
        pg8::EpiResGate E{x, X1, mod + 2 * DM, DM};
        pg8::gemm_phase<pg8::EpiResGate, pg8::StaticOrder, true, true>(lds, g, S, E);
    }
    SEAM(4);
    if (IN(5)) norm_mod_pass(X1, 0, SEQ, H, norm_mlp_w, mod + 3 * DM, mod + 4 * DM, gw, NGW, lane);
    SEAM(5);
    if (IN(6)) {
        pg8::Gemm g{H, Wup_t, SEQ, DFF, DM}; pg8::StaticOrder S; S.init(SEQ, DFF, G, bx);
        pg8::EpiRelu2 E{ACT, DFF};
        pg8::gemm_phase<pg8::EpiRelu2, pg8::StaticOrder, true, true>(lds, g, S, E);
    }
    SEAM(6);
    if (IN(7)) {
        pg8::Gemm g{ACT, Wdn_t, SEQ, DM, DFF}; pg8::StaticOrder S; S.init(SEQ, DM, G, bx);
        pg8::EpiResGate E{X1, X1, mod + 5 * DM, DM};
        pg8::gemm_phase<pg8::EpiResGate, pg8::StaticOrder, true, true>(lds, g, S, E);
    }
    SEAM(7);
    if (IN(8)) {
        f32x4 wv[8];
#pragma unroll
        for (int j = 0; j < 8; ++j) wv[j] = *(const f32x4*)(final_w + 4 * lane + 256 * j);
        for (int m = gw; m < SEQ; m += NGW) {
            const f32x4* xr = (const f32x4*)(X1 + (size_t)m * DM) + lane; f32x4 v[8]; float ss = 0.f;
#pragma unroll
            for (int j = 0; j < 8; ++j) { v[j] = xr[64 * j]; ss += (v[j].x * v[j].x + v[j].y * v[j].y) + (v[j].z * v[j].z + v[j].w * v[j].w); }
            const float rstd = 1.0f / sqrtf(wave_sum(ss) * (1.f / DM) + EPS);
            f32x4* orow = (f32x4*)(args.out + (size_t)m * DM) + lane;
#pragma unroll
            for (int j = 0; j < 8; ++j) orow[64 * j] = v[j] * rstd * wv[j];
        }
    }
#undef IN
#undef SEAM
}

extern "C" void kernel_launch(void* const* d_in, const int* in_sizes, int n_in, void* d_out, int out_size, void* d_ws, size_t ws_size, hipStream_t stream) {
    static int grid = 0;
    if (grid == 0) {
        if (n_in != 16 || out_size != SEQ * DM || ws_size < WS_END) { fprintf(stderr, "kernel_launch: unexpected shapes (n_in %d out %d ws %zu)\n", n_in, out_size, ws_size); grid = -1; return; }
        int dev = 0, cus = 0, per_cu = 0;
        hipGetDevice(&dev); hipDeviceGetAttribute(&cus, hipDeviceAttributeMultiprocessorCount, dev);
        if (hipFuncSetAttribute((const void*)fwd_megakernel, hipFuncAttributeMaxDynamicSharedMemorySize, LDS_BYTES) != hipSuccess) { fprintf(stderr, "kernel_launch: hipFuncSetAttribute failed\n"); grid = -1; return; }
        if (hipOccupancyMaxActiveBlocksPerMultiprocessor(&per_cu, (const void*)fwd_megakernel, NTHR, LDS_BYTES) != hipSuccess || per_cu < 1) { fprintf(stderr, "kernel_launch: occupancy query says %d: not launching\n", per_cu); grid = -1; return; }
        (void)hipGetLastError();
        grid = cus;
        fprintf(stderr, "kernel_launch: grid %d (cus %d, per_cu %d)\n", grid, cus, per_cu);
    }
    if (grid < 0) return;
    hipMemsetAsync((char*)d_ws + WS_CTL, 0, CTL_ZERO_BYTES, stream);
    Args a{};
    for (int i = 0; i < 16; ++i) a.in[i] = (const float*)d_in[i];
    a.out = (float*)d_out; a.ws = (unsigned char*)d_ws;
    for (int li = 0; li < NL; ++li) {
        a.ph_lo = (NL == 1) ? 0 : li; a.ph_hi = (NL == 1) ? NPHASE : li + 1;
        void* kargs[] = {&a};
        hipError_t e = hipLaunchCooperativeKernel((const void*)fwd_megakernel, dim3(grid), dim3(NTHR), kargs, LDS_BYTES, stream);
        if (e != hipSuccess) { fprintf(stderr, "kernel_launch: cooperative launch failed: %s\n", hipGetErrorString(e)); break; }
    }
}
```
